# Optimizing an MI355X kernel written in HIP

```python
import math
import jax, jax.numpy as jnp
from jax import lax
import numpy as np

D_MODEL = 1024
BATCH = 4
SEQ = 4096
DEPTH = 1
DEC_BATCH = 32
DEC_SEQ = 8
PAST_LEN = 8192
PAGE_SIZE = 128

D_MIX = 2 * D_MODEL
HEAD_DIM = 64
D_ATT = D_MIX // 2
N_ATT_HEADS = D_ATT // HEAD_DIM
DILATED_BRANCHES = ((128, 1), (512, 4), (2048, 16))
MAX_WINDOW = 2048
Q_BLOCK = 128
D_SSM = D_MIX - D_ATT
N_SSM_HEADS = D_SSM // HEAD_DIM
SSM_STATE = 128
N_SSM_GROUPS = 4
CONV_WIDTH = 4
SSD_CHUNK = 128
D_CONV = D_SSM + 2 * N_SSM_GROUPS * SSM_STATE
D_FF = ((-(-8 * D_MODEL // 3) + 255) // 256) * 256
D_IN_PROJ = 3 * D_ATT + D_SSM + D_CONV + N_SSM_HEADS
DEEPNORM_ALPHA = (2.0 * DEPTH) ** 0.25
DEEPNORM_BETA = (8.0 * DEPTH) ** -0.25
LN_EPS = 1e-5
RMS_EPS = 1e-5

kernel_name = "hymba_longnet_ssd_deepnorm_step"


def _alibi_slopes():
    n = N_ATT_HEADS
    return jnp.asarray(2.0 ** (-8.0 * np.arange(1, n + 1) / n), dtype=jnp.float32)


def _layer_norm(x, g, b):
    xf = x.astype(jnp.float32)
    mu = jnp.mean(xf, -1, keepdims=True)
    var = jnp.mean(jnp.square(xf - mu), -1, keepdims=True)
    y = (xf - mu) * lax.rsqrt(var + LN_EPS) * g.astype(jnp.float32) + b.astype(jnp.float32)
    return y.astype(x.dtype)


def _rms_norm(xf, g):
    return xf * lax.rsqrt(jnp.mean(jnp.square(xf), -1, keepdims=True) + RMS_EPS) * g.astype(jnp.float32)


def _dilated_block(q, qpos, k, v, slopes):
    qf = q.astype(jnp.float32) * (HEAD_DIM ** -0.5)
    outs, lses = [], []
    for window, dil in DILATED_BRANCHES:
        dist = jnp.arange(window // dil + 1, dtype=jnp.int32) * dil
        idx = qpos[:, None] - dist[None, :]
        valid = idx >= 0
        idx = jnp.clip(idx, 0, k.shape[1] - 1)
        kg = jnp.take(k, idx, axis=1).astype(jnp.float32)
        vg = jnp.take(v, idx, axis=1).astype(jnp.float32)
        s = jnp.einsum('bqhd,bqjhd->bhqj', qf, kg)
        s = s - slopes[:, None, None] * dist.astype(jnp.float32)[None, None, :]
        s = jnp.where(valid[None, None], s, -jnp.inf)
        m = jnp.max(s, -1, keepdims=True)
        p = jnp.exp(s - m)
        den = jnp.sum(p, -1, keepdims=True)
        outs.append(jnp.einsum('bhqj,bqjhd->bqhd', p / den, vg))
        lses.append((m + jnp.log(den))[..., 0])
    w = jax.nn.softmax(jnp.stack(lses, 0), axis=0)
    w = jnp.transpose(w, (0, 1, 3, 2))[..., None]
    return jnp.sum(w * jnp.stack(outs, 0), axis=0)


def _dilated_attention(q, k, v, q_start, slopes):
    b, t, h, dh = q.shape
    if t % Q_BLOCK == 0 and t > Q_BLOCK:
        nb = t // Q_BLOCK
        qb = jnp.moveaxis(q.reshape(b, nb, Q_BLOCK, h, dh), 1, 0)

        def one(args):
            q_blk, i = args
            qpos = q_start + i * Q_BLOCK + jnp.arange(Q_BLOCK, dtype=jnp.int32)
            return _dilated_block(q_blk, qpos, k, v, slopes)

        out = lax.map(one, (qb, jnp.arange(nb, dtype=jnp.int32)))
        return jnp.moveaxis(out, 0, 1).reshape(b, t, h, dh)
    qpos = q_start + jnp.arange(t, dtype=jnp.int32)
    return _dilated_block(q, qpos, k, v, slopes)


def _ssd_chunked(x, dt, a, b_in, c_in, h0):
    bsz, t, h, p = x.shape
    g, n = b_in.shape[2], b_in.shape[3]
    r = h // g
    L = SSD_CHUNK if t % SSD_CHUNK == 0 else t
    nc = t // L
    xdt = (x * dt[..., None]).reshape(bsz, nc, L, g, r, p)
    la = (dt * a).reshape(bsz, nc, L, g, r)
    bc = b_in.reshape(bsz, nc, L, g, n)
    cc = c_in.reshape(bsz, nc, L, g, n)
    cs = jnp.cumsum(la, axis=2)
    seg = cs[:, :, :, None] - cs[:, :, None, :]
    causal = jnp.tril(jnp.ones((L, L), dtype=bool))[None, None, :, :, None, None]
    decay = jnp.exp(jnp.where(causal, seg, -jnp.inf))
    cb = jnp.einsum('bclgn,bcsgn->bclsg', cc, bc)
    y_diag = jnp.einsum('bclsg,bclsgr,bcsgrp->bclgrp', cb, decay, xdt)
    to_end = jnp.exp(cs[:, :, -1:] - cs)
    chunk_states = jnp.einsum('bclgn,bclgr,bclgrp->bcgrpn', bc, to_end, xdt)
    chunk_decay = jnp.exp(cs[:, :, -1])

    def step(hc, inp):
        st, dec = inp
        return hc * dec[..., None, None] + st, hc

    h_fin, h_prev = lax.scan(step, h0.reshape(bsz, g, r, p, n),
                             (jnp.moveaxis(chunk_states, 1, 0), jnp.moveaxis(chunk_decay, 1, 0)))
    y_off = jnp.einsum('bclgn,cbgrpn,bclgr->bclgrp', cc, h_prev, jnp.exp(cs))
    y = (y_diag + y_off).reshape(bsz, t, h, p)
    return y, h_fin.reshape(bsz, h, p, n)


def _hybrid_layer(x, k_past, v_past, conv_prefix, h0, w_in, conv_w, conv_b, dt_bias, a_log,
                  d_skip, attn_norm_g, ssm_norm_g, w_out, ln1_g, ln1_b, w_gate, w_up, w_down,
                  ln2_g, ln2_b):
    f32 = jnp.float32
    bsz, t, _ = x.shape
    proj = x @ w_in
    cuts = np.cumsum([D_ATT, D_ATT, D_ATT, D_SSM, D_CONV])
    q, k, v, z, xbc_raw, dt_raw = jnp.split(proj, cuts, axis=-1)
    q = q.reshape(bsz, t, N_ATT_HEADS, HEAD_DIM)
    k = k.reshape(bsz, t, N_ATT_HEADS, HEAD_DIM)
    v = v.reshape(bsz, t, N_ATT_HEADS, HEAD_DIM)

    k_all = jnp.concatenate([k_past.astype(k.dtype), k], axis=1)
    v_all = jnp.concatenate([v_past.astype(v.dtype), v], axis=1)
    attn = _dilated_attention(q, k_all, v_all, k_past.shape[1], _alibi_slopes())
    attn = _rms_norm(attn.reshape(bsz, t, D_ATT), attn_norm_g)

    xpad = jnp.concatenate([conv_prefix.astype(f32), xbc_raw.astype(f32)], axis=1)
    conv_new = xpad[:, -(CONV_WIDTH - 1):]
    xbc = lax.conv_general_dilated(xpad, conv_w.astype(f32)[:, None, :], window_strides=(1,),
                                   padding='VALID', dimension_numbers=('NWC', 'WIO', 'NWC'),
                                   feature_group_count=D_CONV) + conv_b.astype(f32)
    xbc = jax.nn.silu(xbc)
    xs, bs, cs_ = jnp.split(xbc, [D_SSM, D_SSM + N_SSM_GROUPS * SSM_STATE], axis=-1)
    xs = xs.reshape(bsz, t, N_SSM_HEADS, HEAD_DIM)
    bs = bs.reshape(bsz, t, N_SSM_GROUPS, SSM_STATE)
    cs_ = cs_.reshape(bsz, t, N_SSM_GROUPS, SSM_STATE)
    dt = jax.nn.softplus(dt_raw.astype(f32) + dt_bias.astype(f32))
    a = -jnp.exp(a_log.astype(f32))
    y_ssm, h_fin = _ssd_chunked(xs, dt, a, bs, cs_, h0.astype(f32))
    y_ssm = (y_ssm + d_skip.astype(f32)[:, None] * xs).reshape(bsz, t, D_SSM)
    y_ssm = _rms_norm(y_ssm * jax.nn.silu(z.astype(f32)), ssm_norm_g)

    mix = jnp.concatenate([attn, y_ssm], axis=-1).astype(x.dtype) @ w_out
    hdn = _layer_norm(DEEPNORM_ALPHA * x + mix, ln1_g, ln1_b)
    ffn = (jax.nn.silu(hdn @ w_gate) * (hdn @ w_up)) @ w_down
    y = _layer_norm(DEEPNORM_ALPHA * hdn + ffn, ln2_g, ln2_b)
    return y, k, v, h_fin.astype(x.dtype), conv_new.astype(x.dtype)


def setup_inputs(seed: int = 0) -> dict:
    key = jax.random.key(seed)
    ks = jax.random.split(key, 24)
    nrm = jax.random.normal
    wb = min(MAX_WINDOW, PAST_LEN)
    dt0 = jnp.exp(jax.random.uniform(ks[10], (DEPTH, N_SSM_HEADS), minval=math.log(1e-3), maxval=math.log(1e-1)))
    return {
        "x_prompt": nrm(ks[0], (BATCH, SEQ, D_MODEL), jnp.float32),
        "x_sample": nrm(ks[1], (DEC_BATCH, DEC_SEQ, D_MODEL), jnp.float32),
        "cache_k_win": nrm(ks[2], (DEPTH, DEC_BATCH, wb, N_ATT_HEADS, HEAD_DIM), jnp.float32),
        "cache_v_win": nrm(ks[3], (DEPTH, DEC_BATCH, wb, N_ATT_HEADS, HEAD_DIM), jnp.float32),
        "state_ssm": 0.1 * nrm(ks[4], (DEPTH, DEC_BATCH, N_SSM_HEADS, HEAD_DIM, SSM_STATE), jnp.float32),
        "state_conv": nrm(ks[5], (DEPTH, DEC_BATCH, CONV_WIDTH - 1, D_CONV), jnp.float32),
        "w_in": nrm(ks[6], (DEPTH, D_MODEL, D_IN_PROJ), jnp.float32) * D_MODEL ** -0.5,
        "conv_w": nrm(ks[7], (DEPTH, CONV_WIDTH, D_CONV), jnp.float32) * CONV_WIDTH ** -0.5,
        "conv_b": 0.01 * nrm(ks[8], (DEPTH, D_CONV), jnp.float32),
        "dt_bias": dt0 + jnp.log(-jnp.expm1(-dt0)),
        "a_log": jnp.log(jax.random.uniform(ks[11], (DEPTH, N_SSM_HEADS), minval=1.0, maxval=16.0)),
        "d_skip": 1.0 + 0.1 * nrm(ks[12], (DEPTH, N_SSM_HEADS), jnp.float32),
        "attn_norm_g": 1.0 + 0.05 * nrm(ks[13], (DEPTH, D_ATT), jnp.float32),
        "ssm_norm_g": 1.0 + 0.05 * nrm(ks[14], (DEPTH, D_SSM), jnp.float32),
        "w_out": nrm(ks[15], (DEPTH, D_MIX, D_MODEL), jnp.float32) * (D_MIX ** -0.5 * DEEPNORM_BETA),
        "ln1_g": 1.0 + 0.05 * nrm(ks[16], (DEPTH, D_MODEL), jnp.float32),
        "ln1_b": 0.01 * nrm(ks[17], (DEPTH, D_MODEL), jnp.float32),
        "w_gate": nrm(ks[18], (DEPTH, D_MODEL, D_FF), jnp.float32) * D_MODEL ** -0.5,
        "w_up": nrm(ks[19], (DEPTH, D_MODEL, D_FF), jnp.float32) * D_MODEL ** -0.5,
        "w_down": nrm(ks[20], (DEPTH, D_FF, D_MODEL), jnp.float32) * (D_FF ** -0.5 * DEEPNORM_BETA),
        "ln2_g": 1.0 + 0.05 * nrm(ks[21], (DEPTH, D_MODEL), jnp.float32),
        "ln2_b": 0.01 * nrm(ks[22], (DEPTH, D_MODEL), jnp.float32),
    }


def reference(x_prompt, x_sample, cache_k_win, cache_v_win, state_ssm, state_conv, w_in, conv_w,
              conv_b, dt_bias, a_log, d_skip, attn_norm_g, ssm_norm_g, w_out, ln1_g, ln1_b,
              w_gate, w_up, w_down, ln2_g, ln2_b):
    bp, tp, _ = x_prompt.shape
    keep = min(MAX_WINDOW, tp)
    hp, hs = x_prompt, x_sample
    kp_l, vp_l, sp_l, cp_l, ks_l, vs_l, ss_l, cs_l = [], [], [], [], [], [], [], []
    for l in range(DEPTH):
        w = (w_in[l], conv_w[l], conv_b[l], dt_bias[l], a_log[l], d_skip[l], attn_norm_g[l],
             ssm_norm_g[l], w_out[l], ln1_g[l], ln1_b[l], w_gate[l], w_up[l], w_down[l],
             ln2_g[l], ln2_b[l])
        k0 = jnp.zeros((bp, 0, N_ATT_HEADS, HEAD_DIM), hp.dtype)
        c0 = jnp.zeros((bp, CONV_WIDTH - 1, D_CONV), hp.dtype)
        s0 = jnp.zeros((bp, N_SSM_HEADS, HEAD_DIM, SSM_STATE), hp.dtype)
        hp, kp, vp, sp, cp = _hybrid_layer(hp, k0, k0, c0, s0, *w)
        kp_l.append(kp[:, tp - keep:]); vp_l.append(vp[:, tp - keep:]); sp_l.append(sp); cp_l.append(cp)
        hs, kn, vn, sn, cn = _hybrid_layer(hs, cache_k_win[l], cache_v_win[l], state_conv[l],
                                           state_ssm[l], *w)
        ks_l.append(kn); vs_l.append(vn); ss_l.append(sn); cs_l.append(cn)
    return (hp, hs, jnp.stack(kp_l), jnp.stack(vp_l), jnp.stack(sp_l), jnp.stack(cp_l),
            jnp.stack(ks_l), jnp.stack(vs_l), jnp.stack(ss_l), jnp.stack(cs_l))
```

```cpp
#include <hip/hip_runtime.h>
#include <hip/hip_cooperative_groups.h>
#include <cstdio>
#include <cstdint>
namespace cg = cooperative_groups;
namespace pg8 {
#define PG8_LAS __attribute__((address_space(3)))
typedef unsigned short bf16_t;
typedef short bf16x8 __attribute__((ext_vector_type(8)));
typedef float f32x4 __attribute__((ext_vector_type(4)));
typedef unsigned u32x4 __attribute__((ext_vector_type(4)));
constexpr int BM = 256, BK = 64, HALF = 128, HTB = HALF * BK * 2  , STAGE_BYTES = 8 * HTB, NXCD = 8, WGM = 8;

__host__ __device__ __forceinline__ int lds_byte(int r, int c) { const int st = (r >> 4) * 2 + (c >> 5), rr = r & 15, cc = c & 31, ob = rr * 64 + cc * 2; return st * 1024 + (ob ^ (((ob >> 9) & 1) << 5)); }
__host__ __device__ __forceinline__ void stage_rc(int b, int& R, int& C) { const int st = b / 1024, sb = b % 1024, swz = sb ^ (((sb >> 9) & 1) << 5); R = (st >> 1) * 16 + swz / 64; C = (st & 1) * 32 + (swz % 64) / 2; }
__host__ __device__ __forceinline__ int perm32(int rho) { const int n = rho >> 4, i = rho & 15; return 8 * (i >> 2) + 4 * n + (i & 3); }

struct Unit { int pm, pn; };
struct Gemm { const bf16_t* A; const bf16_t* Bt; int M, N, K; };

struct StaticOrder {
    int nM, nN, nwg, G, c;
    __host__ __device__ void init(int M, int N, int G_, int c_) { nM = M / BM; nN = N / BM; nwg = nM * nN; G = G_; c = c_; }
    __host__ __device__ bool next(int i, Unit& u) const {
        const long L = (long)i * G + c; if (L >= nwg) return false;
        int wgid = (int)L; { const int q = nwg / NXCD, r = nwg % NXCD, xcd = wgid % NXCD, off = wgid / NXCD; wgid = (xcd < r ? xcd * (q + 1) : r * (q + 1) + (xcd - r) * q) + off; }
        const int nig = WGM * nN, gid = wgid / nig, fm = gid * WGM, gsz = (nM - fm) < WGM ? (nM - fm) : WGM;
        u.pm = fm + ((wgid % nig) % gsz); u.pn = (wgid % nig) / gsz; return true;
    }
    __device__ __forceinline__ void a_ready(const Unit&) const {}
    __device__ __forceinline__ void done(const Unit&) const {}
};

__device__ __forceinline__ unsigned cvt_pk_bf16(float lo, float hi) { unsigned r; asm volatile("v_cvt_pk_bf16_f32 %0, %1, %2" : "=v"(r) : "v"(lo), "v"(hi)); return r; }
template <class Epi, class Sched, bool ALIGN_EPI = false, bool SP2 = false>
__device__ __forceinline__ void gemm_phase(PG8_LAS unsigned char* lds, const Gemm g, const Sched& S, const Epi& E) {
    int tid_ = threadIdx.x; asm volatile("" : "+v"(tid_));
    const int tid = tid_, wid = __builtin_amdgcn_readfirstlane(tid >> 6), lane = tid & 63, wr = wid >> 2, wc = wid & 3, fr = lane & 15, fq = lane >> 4;
    const int K = g.K, nt = K / BK;
    unsigned voffA[2], voffB[2];
#pragma unroll
    for (int i = 0; i < 2; ++i) { int R, C; stage_rc(tid * 16 + i * 8192, R, C); const int Rb = Epi::PERM ? ((R & ~31) + perm32(R & 31)) : R;
        voffA[i] = (unsigned)(R * K + C) * 2u; voffB[i] = (unsigned)(Rb * K + C) * 2u; }
    const size_t kstep = (size_t)(BK * 2);
    const size_t hstep = (size_t)HALF * K * 2;
    const size_t tstep = 2 * hstep;
    const unsigned ldsw = (unsigned)wid * 1024u;
    const int aoff = lds_byte(wr * 64 + fr, fq * 8), boff = lds_byte(wc * 32 + fr, fq * 8);
#define PG8_SA(b, h) (((b) * 2 + (h)) * HTB)
#define PG8_SB(b, h) ((4 + (b) * 2 + (h)) * HTB)
#define PG8_STAGE(bufoff, gbase, voff) do { _Pragma("unroll") for (int _i = 0; _i < 2; ++_i) \
        __builtin_amdgcn_global_load_lds((const unsigned*)((const char*)(gbase) + (voff)[_i]), (PG8_LAS unsigned*)(lds + (bufoff) + ldsw + _i * 8192), 16, 0, 0); } while (0)
#define PG8_LDA(dst, b, h) do { _Pragma("unroll") for (int m = 0; m < 4; ++m) _Pragma("unroll") for (int k = 0; k < 2; ++k) dst[m][k] = *(const PG8_LAS bf16x8*)(lds + PG8_SA(b, h) + aoff + m * 2048 + k * 1024); } while (0)
#define PG8_LDB(dst, b, h) do { _Pragma("unroll") for (int n = 0; n < 2; ++n) _Pragma("unroll") for (int k = 0; k < 2; ++k) dst[n][k] = *(const PG8_LAS bf16x8*)(lds + PG8_SB(b, h) + boff + n * 2048 + k * 1024); } while (0)
#define PG8_MMA(ai, bj, At, Bt) do { __builtin_amdgcn_s_setprio(1); _Pragma("unroll") for (int m = 0; m < 4; ++m) _Pragma("unroll") for (int n = 0; n < 2; ++n) _Pragma("unroll") for (int k = 0; k < 2; ++k) \
        acc[ai][bj][m][n] = __builtin_amdgcn_mfma_f32_16x16x32_bf16(Bt[n][k], At[m][k], acc[ai][bj][m][n], 0, 0, 0); __builtin_amdgcn_s_setprio(0); } while (0)
#define PG8_WAIT_V(n) asm volatile("s_waitcnt vmcnt(" #n ")" ::: "memory")
#define PG8_WAIT_L(n) asm volatile("s_waitcnt lgkmcnt(" #n ")" ::: "memory")
#define PG8_BAR __builtin_amdgcn_s_barrier()
#define PG8_SCHED __builtin_amdgcn_sched_barrier(0)
    Unit cur, nxt; int ui = 0;
    if (!S.next(0, cur)) return;
    f32x4 acc[2][2][4][2];
#pragma unroll
    for (int a = 0; a < 2; ++a)
#pragma unroll
        for (int b = 0; b < 2; ++b)
#pragma unroll
            for (int m = 0; m < 4; ++m)
#pragma unroll
                for (int n = 0; n < 2; ++n) acc[a][b][m][n] = (f32x4){0.f, 0.f, 0.f, 0.f};
    bf16x8 At[4][2], B0[2][2], B1[2][2];
    const char* cA = (const char*)g.A + (size_t)cur.pm * tstep; const char* cB = (const char*)g.Bt + (size_t)cur.pn * tstep;
    S.a_ready(cur);
    if constexpr (SP2) {
        PG8_STAGE(PG8_SB(0, 0), cB, voffB); PG8_STAGE(PG8_SB(0, 1), cB + hstep, voffB); PG8_STAGE(PG8_SA(0, 0), cA, voffA); PG8_STAGE(PG8_SA(0, 1), cA + hstep, voffA);
        if (wr == 1) PG8_BAR;
        PG8_WAIT_V(2); PG8_BAR;
        PG8_STAGE(PG8_SB(1, 0), cB + kstep, voffB); PG8_STAGE(PG8_SA(1, 0), cA + kstep, voffA); PG8_STAGE(PG8_SB(1, 1), cB + hstep + kstep, voffB);
        PG8_WAIT_V(6); PG8_BAR;
    } else {
        PG8_STAGE(PG8_SB(0, 0), cB, voffB); PG8_STAGE(PG8_SA(0, 0), cA, voffA); PG8_STAGE(PG8_SB(0, 1), cB + hstep, voffB); PG8_STAGE(PG8_SA(0, 1), cA + hstep, voffA);
        if (wr == 1) PG8_BAR;
        PG8_WAIT_V(4); PG8_BAR;
        PG8_STAGE(PG8_SB(1, 0), cB + kstep, voffB); PG8_STAGE(PG8_SA(1, 0), cA + kstep, voffA); PG8_STAGE(PG8_SB(1, 1), cB + hstep + kstep, voffB);
        PG8_WAIT_V(6); PG8_BAR;
    }
    for (;;) {
        const bool has_next = S.next(ui + 1, nxt);
        const char* nA = has_next ? (const char*)g.A + (size_t)nxt.pm * tstep : cA; const char* nB = has_next ? (const char*)g.Bt + (size_t)nxt.pn * tstep : cB;
        for (int t = 0; t < nt; t += 2) {
            const bool last = (t == nt - 2);
            const char* a1 = cA + (size_t)(t + 1) * kstep;
            const char* a2 = last ? nA : cA + (size_t)(t + 2) * kstep; const char* b2 = last ? nB : cB + (size_t)(t + 2) * kstep;
            const char* a3 = a2 + kstep; const char* b3 = b2 + kstep;
            if (last && has_next) S.a_ready(nxt);
            if constexpr (SP2) {
            PG8_LDB(B0, 0, 0); PG8_LDB(B1, 0, 1); PG8_SCHED; PG8_LDA(At, 0, 0); PG8_STAGE(PG8_SA(1, 1), a1 + hstep, voffA);
            PG8_WAIT_V(8); PG8_WAIT_L(0); PG8_BAR; PG8_MMA(0, 0, At, B0); PG8_MMA(0, 1, At, B1); PG8_BAR; PG8_SCHED;
            PG8_LDA(At, 0, 1); PG8_STAGE(PG8_SB(0, 0), b2, voffB); PG8_STAGE(PG8_SB(0, 1), b2 + hstep, voffB); PG8_STAGE(PG8_SA(0, 0), a2, voffA);
            PG8_WAIT_V(8); PG8_WAIT_L(0); PG8_BAR; PG8_MMA(1, 0, At, B0); PG8_MMA(1, 1, At, B1); PG8_BAR; PG8_SCHED;
            PG8_LDB(B0, 1, 0); PG8_LDB(B1, 1, 1); PG8_SCHED; PG8_LDA(At, 1, 0); PG8_STAGE(PG8_SA(0, 1), a2 + hstep, voffA);
            PG8_WAIT_V(8); PG8_WAIT_L(0); PG8_BAR; PG8_MMA(0, 0, At, B0); PG8_MMA(0, 1, At, B1); PG8_BAR; PG8_SCHED;
            PG8_LDA(At, 1, 1); PG8_STAGE(PG8_SB(1, 0), b3, voffB); PG8_STAGE(PG8_SB(1, 1), b3 + hstep, voffB); PG8_STAGE(PG8_SA(1, 0), a3, voffA);
            PG8_WAIT_V(8); PG8_WAIT_L(0); PG8_BAR; PG8_MMA(1, 0, At, B0); PG8_MMA(1, 1, At, B1); PG8_BAR; PG8_SCHED;
            } else {
            PG8_LDB(B0, 0, 0); PG8_SCHED; PG8_LDA(At, 0, 0); PG8_STAGE(PG8_SA(1, 1), a1 + hstep, voffA);
            PG8_WAIT_L(8); PG8_BAR; PG8_WAIT_L(0); PG8_MMA(0, 0, At, B0); PG8_BAR; PG8_SCHED;
            PG8_LDB(B1, 0, 1); PG8_STAGE(PG8_SB(0, 0), b2, voffB);
            PG8_BAR; PG8_WAIT_L(0); PG8_MMA(0, 1, At, B1); PG8_BAR;
            PG8_LDA(At, 0, 1); PG8_STAGE(PG8_SA(0, 0), a2, voffA);
            PG8_BAR; PG8_WAIT_L(0); PG8_MMA(1, 0, At, B0); PG8_BAR; PG8_SCHED;
            PG8_STAGE(PG8_SB(0, 1), b2 + hstep, voffB);
            PG8_WAIT_V(6); PG8_BAR; PG8_MMA(1, 1, At, B1); PG8_BAR;
            PG8_LDB(B0, 1, 0); PG8_SCHED; PG8_LDA(At, 1, 0); PG8_STAGE(PG8_SA(0, 1), a2 + hstep, voffA);
            PG8_WAIT_L(8); PG8_BAR; PG8_WAIT_L(0); PG8_MMA(0, 0, At, B0); PG8_BAR; PG8_SCHED;
            PG8_LDB(B1, 1, 1); PG8_STAGE(PG8_SB(1, 0), b3, voffB);
            PG8_BAR; PG8_WAIT_L(0); PG8_MMA(0, 1, At, B1); PG8_BAR;
            PG8_LDA(At, 1, 1); PG8_STAGE(PG8_SA(1, 0), a3, voffA);
            PG8_BAR; PG8_WAIT_L(0); PG8_MMA(1, 0, At, B0); PG8_BAR; PG8_SCHED;
            PG8_STAGE(PG8_SB(1, 1), b3 + hstep, voffB);
            PG8_WAIT_V(6); PG8_BAR; PG8_MMA(1, 1, At, B1); PG8_BAR;
            }
        }
        if constexpr (ALIGN_EPI) { if (wr == 0) PG8_BAR; }
        if constexpr (!Epi::AFTER_DRAIN) { E(acc, cur, wr, wc, fr, fq); S.done(cur); }
        if (!has_next) break;
#pragma unroll
        for (int a = 0; a < 2; ++a)
#pragma unroll
            for (int b = 0; b < 2; ++b)
#pragma unroll
                for (int m = 0; m < 4; ++m)
#pragma unroll
                    for (int n = 0; n < 2; ++n) acc[a][b][m][n] = (f32x4){0.f, 0.f, 0.f, 0.f};
        cur = nxt; cA = nA; cB = nB; ++ui;
        if constexpr (ALIGN_EPI) { if (wr == 1) PG8_BAR; }
    }
    PG8_WAIT_V(0);
    if constexpr (!ALIGN_EPI) { if (wr == 0) PG8_BAR; }
    PG8_BAR;
    if constexpr (Epi::AFTER_DRAIN) { E.fused(acc, cur, wr, wc, fr, fq, lds, wid, lane); S.done(cur); }
#undef PG8_SA
#undef PG8_SB
#undef PG8_STAGE
#undef PG8_LDA
#undef PG8_LDB
#undef PG8_MMA
#undef PG8_WAIT_V
#undef PG8_WAIT_L
#undef PG8_BAR
#undef PG8_SCHED
}
}
#define XB_TMO      128
#define XB_XCNT(j)  (256  + 64 * (j))
#define XB_XSUB(j)  (1280 + 64 * (j))
#define XB_XGEN(j)  (2304 + 64 * (j))
#define XB_TOP      3328
#define XB_TOPGEN   3392
#define XCD_BAR_WORDS 3456
#define XB_SPIN_CAP (1u << 18)
#define LAS __attribute__((address_space(3)))

__device__ __forceinline__ unsigned xb_ld(unsigned* p)              { return __hip_atomic_load(p, __ATOMIC_RELAXED, __HIP_MEMORY_SCOPE_AGENT); }
__device__ __forceinline__ unsigned xb_add(unsigned* p, unsigned v) { return __hip_atomic_fetch_add(p, v, __ATOMIC_RELAXED, __HIP_MEMORY_SCOPE_AGENT); }
__device__ __forceinline__ unsigned xb_xcc_id() { return (unsigned)__builtin_amdgcn_s_getreg((3 << 11) | 20) & 0xFu; }
#define XB_SPIN(cond, bar) do { unsigned _sp = 0; while (cond) { __builtin_amdgcn_s_sleep(1); \
    if ((++_sp & 255u) == 0u) { if (xb_ld(&(bar)[XB_TMO])) break; if (_sp > XB_SPIN_CAP) { atomicAdd(&(bar)[XB_TMO], 1u); break; } } } } while (0)

struct XcdBarrier {
    unsigned* bar; unsigned x;
    volatile LAS unsigned* st;
};

__device__ __forceinline__ XcdBarrier xcd_barrier_post(unsigned* bar, volatile LAS unsigned* st) {
    XcdBarrier b; b.bar = bar; b.x = xb_xcc_id(); b.st = st;
    if (threadIdx.x == 0) (void)xb_add(&bar[XB_XCNT(b.x)], 1u);
    return b;
}
__device__ __forceinline__ void xcd_barrier_complete(unsigned* bar, unsigned x, unsigned& nloc, unsigned& nx) {
    const unsigned G = gridDim.x * gridDim.y * gridDim.z;
    unsigned sum, cnt, mine, sp = 0u;
    for (;;) {
        sum = 0u; cnt = 0u; mine = 0u;
#pragma unroll
        for (unsigned j = 0; j < 16; ++j) { const unsigned c = xb_ld(&bar[XB_XCNT(j)]); sum += c; cnt += (c > 0u) ? 1u : 0u; mine = (j == x) ? c : mine; }
        if (sum == G) break;
        __builtin_amdgcn_s_sleep(1);
        if ((++sp & 255u) == 0u) { if (xb_ld(&bar[XB_TMO])) break; if (sp > XB_SPIN_CAP) { atomicAdd(&bar[XB_TMO], 1u); break; } }
    }
    nloc = mine > 0u ? mine : 1u; nx = cnt > 0u ? cnt : 1u;
}

__device__ __forceinline__ void xcd_barrier(const XcdBarrier& b) {
    asm volatile("s_waitcnt vmcnt(0)" ::: "memory");
    __syncthreads();
    if (threadIdx.x == 0) {
        unsigned* bar = b.bar;
        __builtin_amdgcn_s_waitcnt(0);
        unsigned nloc = b.st[0], nx = b.st[1];
        if (nloc == 0u) { xcd_barrier_complete(bar, b.x, nloc, nx); b.st[0] = nloc; b.st[1] = nx; }
        const unsigned old = xb_add(&bar[XB_XSUB(b.x)], 1u);
        const unsigned gen = old / nloc;
        if (old + 1u == (gen + 1u) * nloc) {
            __builtin_amdgcn_fence(__ATOMIC_RELEASE, "agent");
            asm volatile("s_waitcnt vmcnt(0)" ::: "memory");
            const unsigned og = xb_add(&bar[XB_TOP], 1u);
            const unsigned tg = og / nx;
            if (og + 1u == (tg + 1u) * nx) xb_add(&bar[XB_TOPGEN], 1u);
            else XB_SPIN(xb_ld(&bar[XB_TOPGEN]) == tg, bar);
            __builtin_amdgcn_fence(__ATOMIC_ACQUIRE, "agent");
            xb_add(&bar[XB_XGEN(b.x)], 1u);
            asm volatile("s_waitcnt vmcnt(0)" ::: "memory");
        } else {
            XB_SPIN(xb_ld(&bar[XB_XGEN(b.x)]) == gen, bar);
            __builtin_amdgcn_fence(__ATOMIC_ACQUIRE, "agent");
            asm volatile("s_waitcnt vmcnt(0)" ::: "memory");
        }
    }
    __syncthreads();
}


using pg8::bf16x8; using pg8::f32x4; using pg8::Unit;
typedef unsigned short bfu;
#define LAS3 __attribute__((address_space(3)))

constexpr int MP = 16384, MT = 16640;
constexpr int NPROJ = 6144, NIN = 6160, DFF = 2816;
constexpr float ALPHA = 1.189207115002721f;
constexpr float EPS = 1e-5f;

constexpr size_t O_YP = 0, O_YS = 16777216, O_KP = 17039360, O_VP = 25427968, O_SP = 33816576, O_CP = 34340864,
                 O_KS = 34365440, O_VS = 34627584, O_SS = 34889728, O_CS = 39084032;
constexpr size_t MiB = 1u << 20;
constexpr size_t WS_WIN = 0, WS_WDT = 12 * MiB, WS_WOUT = 13 * MiB, WS_WGU = 17 * MiB, WS_WDN = 28 * MiB, WS_XB = 34 * MiB,
                 WS_PROJ = 67 * MiB, WS_VT = 262 * MiB, WS_DT = 358 * MiB, WS_XBC = 360 * MiB, WS_ATT = 425 * MiB,
                 WS_STATES = 458 * MiB, WS_HPREV = 522 * MiB, WS_DECAY = 554 * MiB, WS_YG = 555 * MiB, WS_MIX = 588 * MiB,
                 WS_PRE = 653 * MiB, WS_ATTB = 653 * MiB  , WS_LSE = 783 * MiB  , WS_HDN = 718 * MiB, WS_HDNB = 783 * MiB, WS_ACT = 816 * MiB, WS_BAR = 906 * MiB  , WS_XCH = 907 * MiB, WS_END = 909 * MiB;
constexpr int CTL_WORDS = 4096 + 2 * 64 * 64 + 2 * 16 * 64;
constexpr size_t VT_SZ = (size_t)64 * 64 * 4096;

struct Params {
    const float *x_prompt, *x_sample, *cache_k, *cache_v, *state_ssm, *state_conv, *w_in, *conv_w, *conv_b, *dt_bias, *a_log,
        *d_skip, *attn_g, *ssm_g, *w_out, *ln1_g, *ln1_b, *w_gate, *w_up, *w_down, *ln2_g, *ln2_b;
    float* out;
    unsigned char* ws;
};

typedef float f32x2_t __attribute__((ext_vector_type(2))); typedef __bf16 bf16x2_t __attribute__((ext_vector_type(2)));
__device__ __forceinline__ unsigned pk2(float lo, float hi) { f32x2_t v = {lo, hi}; bf16x2_t b = __builtin_convertvector(v, bf16x2_t); return __builtin_bit_cast(unsigned, b); }
__device__ __forceinline__ unsigned f2bf(float f) { return pk2(f, 0.f) & 0xffffu; }
__device__ __forceinline__ float bflo(unsigned u) { return __uint_as_float(u << 16); }
__device__ __forceinline__ float bfhi(unsigned u) { return __uint_as_float(u & 0xffff0000u); }
__device__ __forceinline__ float bf2f(bfu h) { return __uint_as_float((unsigned)h << 16); }
__device__ __forceinline__ float silu_f(float x) { return x * __builtin_amdgcn_rcpf(1.f + __builtin_amdgcn_exp2f(x * -1.4426950408889634f)); }
__device__ __forceinline__ float wsum(float v) { v += __shfl_xor(v, 32); v += __shfl_xor(v, 16); v += __shfl_xor(v, 8); v += __shfl_xor(v, 4); v += __shfl_xor(v, 2); v += __shfl_xor(v, 1); return v; }
__device__ __forceinline__ float wmax(float v) { v = fmaxf(v, __shfl_xor(v, 32)); v = fmaxf(v, __shfl_xor(v, 16)); v = fmaxf(v, __shfl_xor(v, 8)); v = fmaxf(v, __shfl_xor(v, 4)); v = fmaxf(v, __shfl_xor(v, 2)); v = fmaxf(v, __shfl_xor(v, 1)); return v; }
template <int CTRL> __device__ __forceinline__ float dppf(float v) { return __int_as_float(__builtin_amdgcn_update_dpp(0, __float_as_int(v), CTRL, 0xf, 0xf, false)); }
__device__ __forceinline__ float rowsum16(float v) { v += dppf<0xB1>(v); v += dppf<0x4E>(v); v += dppf<0x141>(v); v += dppf<0x140>(v); return v; }
#define MFMA16(a, b, c) __builtin_amdgcn_mfma_f32_16x16x32_bf16((a), (b), (c), 0, 0, 0)
__device__ __forceinline__ bf16x8 mk8(uint2 lo, uint2 hi) { uint4 u; u.x = lo.x; u.y = lo.y; u.z = hi.x; u.w = hi.y; return __builtin_bit_cast(bf16x8, u); }
__device__ __forceinline__ bf16x8 ld8g(const bfu* p) { return __builtin_bit_cast(bf16x8, *(const uint4*)p); }

__device__ __forceinline__ void transpose_tile(const float* __restrict__ src, int ld, int N, int K, int k0, int n0, bfu* __restrict__ dst,
                                               int blk, int stride, int off, float* tl  ) {
    const int tid = threadIdx.x;
    {
        const int n4 = (tid & 31) * 4, kk = tid >> 5;
        float4 v[4];
#pragma unroll
        for (int i = 0; i < 4; ++i) v[i] = (n0 + n4 < N) ? *(const float4*)(src + (size_t)(k0 + kk + 16 * i) * ld + n0 + n4) : make_float4(0.f, 0.f, 0.f, 0.f);
#pragma unroll
        for (int i = 0; i < 4; ++i) { float* t = tl + (kk + 16 * i) * 129 + n4; t[0] = v[i].x; t[1] = v[i].y; t[2] = v[i].z; t[3] = v[i].w; }
    }
    __syncthreads();
    {
        const int k2 = (tid & 31) * 2, nn = tid >> 5;
#pragma unroll
        for (int i = 0; i < 8; ++i) {
            const int nl = nn + 16 * i, ng = n0 + nl;
            if (ng < N) { const int row = (ng / blk) * stride + (ng % blk) + off; *(unsigned*)(dst + (size_t)row * K + k0 + k2) = pk2(tl[k2 * 129 + nl], tl[(k2 + 1) * 129 + nl]); }
        }
    }
    __syncthreads();
}

constexpr int J_IN = 16 * 48, J_DT = 16, J_OUT = 32 * 8, J_G = 16 * 22, J_U = 16 * 22, J_D = 44 * 8;
constexpr int NJ_EARLY = J_IN + J_DT, NJ_ALL = NJ_EARLY + J_OUT + J_G + J_U + J_D;
__device__ __forceinline__ void weight_job(const Params& p, int job, float* ldsf) {
    unsigned char* ws = p.ws;
    constexpr int BIG = 1 << 30;
    int j = job;
    if (j < J_IN) { transpose_tile(p.w_in, NIN, 6144, 1024, (j / 48) * 64, (j % 48) * 128, (bfu*)(ws + WS_WIN), BIG, 0, 0, ldsf); return; }
    j -= J_IN;
    if (j < J_DT) { transpose_tile(p.w_in + 6144, NIN, 16, 1024, j * 64, 0, (bfu*)(ws + WS_WDT), BIG, 0, 0, ldsf); return; }
    j -= J_DT;
    if (j < J_OUT) { transpose_tile(p.w_out, 1024, 1024, 2048, (j / 8) * 64, (j % 8) * 128, (bfu*)(ws + WS_WOUT), BIG, 0, 0, ldsf); return; }
    j -= J_OUT;
    if (j < J_G) { transpose_tile(p.w_gate, DFF, DFF, 1024, (j / 22) * 64, (j % 22) * 128, (bfu*)(ws + WS_WGU), 128, 256, 0, ldsf); return; }
    j -= J_G;
    if (j < J_U) { transpose_tile(p.w_up, DFF, DFF, 1024, (j / 22) * 64, (j % 22) * 128, (bfu*)(ws + WS_WGU), 128, 256, 128, ldsf); return; }
    j -= J_U;
    transpose_tile(p.w_down, 1024, 1024, DFF, (j / 8) * 64, (j % 8) * 128, (bfu*)(ws + WS_WDN), BIG, 0, 0, ldsf);
}

__device__ __forceinline__ void phase0(const Params& p, float* ldsf, int bid, int G) {
    unsigned char* ws = p.ws;
    const int nj = (G == 256) ? NJ_EARLY : NJ_ALL;
    for (int job = bid; job < nj; job += G) weight_job(p, job, ldsf);
    bfu* xb = (bfu*)(ws + WS_XB);
    const int NT = G * 512, gt = bid * 512 + threadIdx.x;
    {
        const float4* src = (const float4*)p.x_prompt; constexpr int N4 = MP * 256;
#pragma unroll 1
        for (int i0 = gt; i0 < N4; i0 += 8 * NT) {
            float4 v[8];
#pragma unroll
            for (int k = 0; k < 8; ++k) { const int i = i0 + k * NT; v[k] = src[i < N4 ? i : N4 - 1]; }
#pragma unroll
            for (int k = 0; k < 8; ++k) { const int i = i0 + k * NT; if (i < N4) { uint2 o; o.x = pk2(v[k].x, v[k].y); o.y = pk2(v[k].z, v[k].w); *(uint2*)(xb + (size_t)i * 4) = o; } }
        }
    }
    {
        const float4* src = (const float4*)p.x_sample; constexpr int N4 = (MT - MP) * 256;
        for (int i = gt; i < N4; i += NT) { const float4 v = src[i]; uint2 o; o.x = pk2(v.x, v.y); o.y = pk2(v.z, v.w); *(uint2*)(xb + (size_t)(MP * 256 + i) * 4) = o; }
    }
}
__device__ __forceinline__ void after_p1_filler(const Params& p, float* ldsf, int bid, int G) {
    if (G != 256 || bid < 24) return;
    for (int job = NJ_EARLY + (bid - 24); job < NJ_ALL - J_D; job += 232) weight_job(p, job, ldsf);
}
__device__ __forceinline__ void after_p9_filler(const Params& p, float* ldsf, int bid, int G) {
    if (G != 256 || bid < 150) return;
    for (int job = NJ_ALL - J_D + (bid - 150); job < NJ_ALL; job += 106) weight_job(p, job, ldsf);
}

struct EpiIn {
    static constexpr bool PERM = true, AFTER_DRAIN = false;
    bfu* proj; float* out;
    __device__ __forceinline__ void operator()(const f32x4 (&acc)[2][2][4][2], const Unit& u, int wr, int wc, int fr, int fq) const {
        const int pn = u.pn, pm = u.pm;
        const bool kv = (pn >= 4 && pn < 12), isv = pn >= 8;
        const bool sample = pm >= 64;
        const bool wr_out = kv && (sample || ((pm & 15) >= 8));
#pragma unroll
        for (int ai = 0; ai < 2; ++ai)
#pragma unroll
            for (int m = 0; m < 4; ++m) {
                const int row = pm * 256 + ai * 128 + wr * 64 + m * 16 + fr;
                float* orow = nullptr;
                if (wr_out) {
                    if (sample) orow = out + (isv ? O_VS : O_KS) + (size_t)(row - MP) * 1024;
                    else { const int b = row >> 12, t = row & 4095; orow = out + (isv ? O_VP : O_KP) + ((size_t)(b * 2048 + (t - 2048))) * 1024; }
                }
#pragma unroll
                for (int bj = 0; bj < 2; ++bj) {
                    const int col = pn * 256 + bj * 128 + wc * 32 + fq * 8;
                    const f32x4 v0 = acc[ai][bj][m][0], v1 = acc[ai][bj][m][1];
                    uint4 o; o.x = pk2(v0[0], v0[1]); o.y = pk2(v0[2], v0[3]); o.z = pk2(v1[0], v1[1]); o.w = pk2(v1[2], v1[3]);
                    *(uint4*)(proj + (size_t)row * NPROJ + col) = o;
                    if (wr_out) {
                        const int cc = col - (isv ? 2048 : 1024);
                        if (sample) { *(float4*)(orow + cc) = make_float4(v0[0], v0[1], v0[2], v0[3]); *(float4*)(orow + cc + 4) = make_float4(v1[0], v1[1], v1[2], v1[3]); }
                        else { __builtin_nontemporal_store(v0, (f32x4*)(orow + cc)); __builtin_nontemporal_store(v1, (f32x4*)(orow + cc + 4)); }
                    }
                }
            }
    }
};
struct EpiRes {
    static constexpr bool PERM = false, AFTER_DRAIN = false;
    float* pre; const float* res0; const float* res1;
    __device__ __forceinline__ void operator()(const f32x4 (&acc)[2][2][4][2], const Unit& u, int wr, int wc, int fr, int fq) const {
#pragma unroll
        for (int ai = 0; ai < 2; ++ai)
#pragma unroll
            for (int m = 0; m < 4; ++m) {
                const int row = u.pm * 256 + ai * 128 + wr * 64 + m * 16 + fr;
                const float* rr = (row < MP) ? res0 + (size_t)row * 1024 : res1 + (size_t)(row - MP) * 1024;
#pragma unroll
                for (int bj = 0; bj < 2; ++bj)
#pragma unroll
                    for (int n = 0; n < 2; ++n) {
                        const int col = u.pn * 256 + bj * 128 + wc * 32 + n * 16 + fq * 4;
                        const f32x4 v = acc[ai][bj][m][n];
                        const float4 x = *(const float4*)(rr + col);
                        *(float4*)(pre + (size_t)row * 1024 + col) = make_float4(v[0] + ALPHA * x.x, v[1] + ALPHA * x.y, v[2] + ALPHA * x.z, v[3] + ALPHA * x.w);
                    }
            }
    }
};
struct EpiGU {
    static constexpr bool PERM = true, AFTER_DRAIN = false;
    bfu* act;
    __device__ __forceinline__ void operator()(const f32x4 (&acc)[2][2][4][2], const Unit& u, int wr, int wc, int fr, int fq) const {
#pragma unroll
        for (int ai = 0; ai < 2; ++ai)
#pragma unroll
            for (int m = 0; m < 4; ++m) {
                const int row = u.pm * 256 + ai * 128 + wr * 64 + m * 16 + fr;
                const int col = u.pn * 128 + wc * 32 + fq * 8;
                const f32x4 g0 = acc[ai][0][m][0], g1 = acc[ai][0][m][1], u0 = acc[ai][1][m][0], u1 = acc[ai][1][m][1];
                uint4 o;
                o.x = pk2(silu_f(g0[0]) * u0[0], silu_f(g0[1]) * u0[1]); o.y = pk2(silu_f(g0[2]) * u0[2], silu_f(g0[3]) * u0[3]);
                o.z = pk2(silu_f(g1[0]) * u1[0], silu_f(g1[1]) * u1[1]); o.w = pk2(silu_f(g1[2]) * u1[2], silu_f(g1[3]) * u1[3]);
                *(uint4*)(act + (size_t)row * DFF + col) = o;
            }
    }
};

__device__ __forceinline__ void ld8f(const bfu* p, float (&r)[8]) {
    const uint4 v = *(const uint4*)p;
    r[0] = bflo(v.x); r[1] = bfhi(v.x); r[2] = bflo(v.y); r[3] = bfhi(v.y); r[4] = bflo(v.z); r[5] = bfhi(v.z); r[6] = bflo(v.w); r[7] = bfhi(v.w);
}
__device__ __forceinline__ void ld8f32(const float* p, float (&r)[8]) {
    const float4 a = *(const float4*)p, b = *(const float4*)(p + 4);
    r[0] = a.x; r[1] = a.y; r[2] = a.z; r[3] = a.w; r[4] = b.x; r[5] = b.y; r[6] = b.z; r[7] = b.w;
}
template <bool SAMPLE, int NT>
__device__ __forceinline__ void conv_run(const Params& p, int b, int row0, int t_first, int c) {
    const bfu* proj = (const bfu*)(p.ws + WS_PROJ);
    bfu* xbc = (bfu*)(p.ws + WS_XBC);
    constexpr int T = SAMPLE ? 8 : 4096;
    float w0[8], w1[8], w2[8], w3[8], cb[8];
    ld8f32(p.conv_w + c, w0); ld8f32(p.conv_w + 2048 + c, w1); ld8f32(p.conv_w + 4096 + c, w2); ld8f32(p.conv_w + 6144 + c, w3); ld8f32(p.conv_b + c, cb);
    float r0[8], r1[8], r2[8], r3[8];
    auto getraw = [&](int t, float (&r)[8]) {
        if (t >= 0) ld8f(proj + (size_t)(row0 + t) * NPROJ + 4096 + c, r);
        else if (SAMPLE) ld8f32(p.state_conv + ((size_t)b * 3 + (3 + t)) * 2048 + c, r);
        else {
#pragma unroll
            for (int j = 0; j < 8; ++j) r[j] = 0.f;
        }
    };
    getraw(t_first - 3, r0); getraw(t_first - 2, r1); getraw(t_first - 1, r2);
#pragma unroll
    for (int i = 0; i < NT; ++i) {
        const int t = t_first + i;
        getraw(t, r3);
        float o[8];
#pragma unroll
        for (int j = 0; j < 8; ++j) { const float v = cb[j] + w0[j] * r0[j] + w1[j] * r1[j] + w2[j] * r2[j] + w3[j] * r3[j]; o[j] = silu_f(v); }
        uint4 ov; ov.x = pk2(o[0], o[1]); ov.y = pk2(o[2], o[3]); ov.z = pk2(o[4], o[5]); ov.w = pk2(o[6], o[7]);
        *(uint4*)(xbc + (size_t)(row0 + t) * 2048 + c) = ov;
        if (t >= T - 3) {
            float* dst = p.out + (SAMPLE ? O_CS : O_CP) + ((size_t)b * 3 + (t - (T - 3))) * 2048 + c;
            *(float4*)dst = make_float4(r3[0], r3[1], r3[2], r3[3]); *(float4*)(dst + 4) = make_float4(r3[4], r3[5], r3[6], r3[7]);
        }
#pragma unroll
        for (int j = 0; j < 8; ++j) { r0[j] = r1[j]; r1[j] = r2[j]; r2[j] = r3[j]; }
    }
}

__device__ __forceinline__ void vt_unit(const Params& p, int unit, bfu* tile  ) {
    const int blk = unit & 15, bh = unit >> 4, h = bh & 15, b = bh >> 4, t0 = blk * 256, tid = threadIdx.x;
    const bfu* proj = (const bfu*)(p.ws + WS_PROJ);
    bfu* vt = (bfu*)(p.ws + WS_VT);
#pragma unroll
    for (int i = 0; i < 4; ++i) {
        const int e = tid + 512 * i, t = e >> 3, d8 = (e & 7) * 8;
        const uint4 v = *(const uint4*)(proj + (size_t)(b * 4096 + t0 + t) * NPROJ + 2048 + h * 64 + d8);
        bfu* tp = tile + d8 * 266 + t;
        tp[0] = (bfu)(v.x & 0xffff); tp[266] = (bfu)(v.x >> 16); tp[2 * 266] = (bfu)(v.y & 0xffff); tp[3 * 266] = (bfu)(v.y >> 16);
        tp[4 * 266] = (bfu)(v.z & 0xffff); tp[5 * 266] = (bfu)(v.z >> 16); tp[6 * 266] = (bfu)(v.w & 0xffff); tp[7 * 266] = (bfu)(v.w >> 16);
    }
    __syncthreads();
#pragma unroll
    for (int br = 0; br < 3; ++br) {
        const int dsh = 2 * br, dil = 1 << dsh, nch = (256 >> dsh) >> 3;
#pragma unroll
        for (int i = 0; i < 4; ++i) {
            const int e = tid + 512 * i, d = e >> 5, rem = e & 31, ch = rem % nch, r = rem / nch;
            const bfu* tp = tile + d * 266 + r + ((ch * 8) << dsh);
            uint4 o;
            o.x = (unsigned)tp[0] | ((unsigned)tp[dil] << 16); o.y = (unsigned)tp[2 * dil] | ((unsigned)tp[3 * dil] << 16);
            o.z = (unsigned)tp[4 * dil] | ((unsigned)tp[5 * dil] << 16); o.w = (unsigned)tp[6 * dil] | ((unsigned)tp[7 * dil] << 16);
            *(uint4*)(vt + (size_t)br * VT_SZ + ((size_t)(bh * 64 + d)) * 4096 + r * (4096 >> dsh) + (t0 >> dsh) + ch * 8) = o;
        }
    }
    __syncthreads();
}

__device__ __forceinline__ void dt_task(const Params& p, int wt) {
    const int lane = threadIdx.x & 63, l15 = lane & 15, quad = lane >> 4, r0 = wt * 16;
    const bfu* xb = (const bfu*)(p.ws + WS_XB) + (size_t)(r0 + l15) * 1024 + quad * 8;
    const bfu* wd = (const bfu*)(p.ws + WS_WDT) + (size_t)l15 * 1024 + quad * 8;
    f32x4 acc = {0.f, 0.f, 0.f, 0.f};
#pragma unroll 8
    for (int ks = 0; ks < 32; ++ks) acc = MFMA16(ld8g(xb + ks * 32), ld8g(wd + ks * 32), acc);
    float* dt = (float*)(p.ws + WS_DT);
    const float bias = p.dt_bias[l15];
#pragma unroll
    for (int j = 0; j < 4; ++j) { const float v = acc[j] + bias; dt[(size_t)(r0 + quad * 4 + j) * 16 + l15] = (v > 20.f) ? v : log1pf(__expf(v)); }
}

__device__ __forceinline__ void phase2(const Params& p, unsigned char* lds, int bid, int G) {
    constexpr int U_CP = 0, U_CS = 32, U_VT = 1024, U_DT = 130, NU = U_CP + U_CS + U_VT + U_DT;
    const int tid = threadIdx.x;
    for (int u = bid; u < NU; u += G) {
        int j = u;
        if (j < U_VT) { vt_unit(p, j, (bfu*)lds); continue; }
        j -= U_VT;
        if (j < U_CP) { const int b = j >> 7, tt = j & 127; conv_run<false, 16>(p, b, b * 4096, tt * 32 + (tid >> 8) * 16, (tid & 255) * 8); continue; }
        j -= U_CP;
        if (j < U_CS) { conv_run<true, 4>(p, j, MP + j * 8, (tid >> 8) * 4, (tid & 255) * 8); continue; }
        j -= U_CS;
        { const int wt = j * 8 + (tid >> 6); if (wt < MT / 16) dt_task(p, wt); }
    }
}

struct AttnUnit { int bh, br, r, i_start; };
__device__ __forceinline__ AttnUnit attn_decode(int bh, int br, int sub) {
    AttnUnit u; u.bh = bh; u.br = br;
    u.r = (br == 0) ? 0 : (br == 1 ? (sub & 3) : sub);
    u.i_start = ((br == 0) ? sub : (br == 1 ? (sub >> 2) : 0)) * 256;
    return u;
}
__device__ __forceinline__ void attn_stage_load(const Params& p, const AttnUnit u, uint4 (&sk)[6], uint4 (&sv)[6]) {
    const int h = u.bh & 15, b = u.bh >> 4, tid = threadIdx.x;
    const int dsh = 2 * u.br, nsub = 4096 >> dsh, k_lo = u.i_start - 128;
    const bfu* vt = (const bfu*)(p.ws + WS_VT) + (size_t)u.br * VT_SZ + (size_t)u.bh * 64 * 4096 + u.r * nsub;
    const bfu* kbase = (const bfu*)(p.ws + WS_PROJ) + (size_t)(b * 4096 + u.r) * NPROJ + 1024 + h * 64;
#pragma unroll
    for (int i = 0; i < 6; ++i) {
        const int e = tid + 512 * i;
        { const int key = e >> 3, c = e & 7; int ik = k_lo + key; ik = ik < 0 ? 0 : ik; sk[i] = *(const uint4*)(kbase + ((size_t)ik << dsh) * NPROJ + c * 8); }
        { const int d = e / 48, c = e - d * 48; int ik = k_lo + c * 8; ik = ik < 0 ? 0 : ik; sv[i] = *(const uint4*)(vt + (size_t)d * 4096 + ik); }
    }
}
__device__ __forceinline__ void attn_stage_store(const uint4 (&sk)[6], const uint4 (&sv)[6], unsigned char* ldsb) {
    bfu* Kl = (bfu*)ldsb; bfu* Vl = Kl + 384 * 72; const int tid = threadIdx.x;
#pragma unroll
    for (int i = 0; i < 6; ++i) {
        const int e = tid + 512 * i;
        { const int key = e >> 3, c = e & 7; *(uint4*)(Kl + key * 72 + c * 8) = sk[i]; }
        { const int d = e / 48, c = e - d * 48; *(uint4*)(Vl + d * 392 + c * 8) = sv[i]; }
    }
}
__device__ __forceinline__ void attn_qload(const Params& p, const AttnUnit u, bf16x8 (&qf)[4]) {
    const int h = u.bh & 15, b = u.bh >> 4, lane = threadIdx.x & 63, wave = __builtin_amdgcn_readfirstlane(threadIdx.x >> 6), l15 = lane & 15, quad = lane >> 4, dsh = 2 * u.br;
#pragma unroll
    for (int tt = 0; tt < 2; ++tt) {
        const int tq = u.r + ((u.i_start + 16 * (wave * 2 + tt) + l15) << dsh);
        const bfu* qp = (const bfu*)(p.ws + WS_PROJ) + (size_t)(b * 4096 + tq) * NPROJ + h * 64 + quad * 8;
        qf[2 * tt] = ld8g(qp); qf[2 * tt + 1] = ld8g(qp + 32);
    }
}
__device__ __forceinline__ void attn_compute(const Params& p, const AttnUnit u, unsigned char* ldsb, const bf16x8 (&qf)[4]) {
    const int bh = u.bh, br = u.br, r = u.r, i_start = u.i_start;
    const int h = bh & 15, b = bh >> 4;
    const int tid = threadIdx.x, lane = tid & 63, wave = __builtin_amdgcn_readfirstlane(tid >> 6), l15 = lane & 15, quad = lane >> 4;
    const bfu* Kl = (const bfu*)ldsb;
    const bfu* Vl = Kl + 384 * 72;
    const bfu* proj = (const bfu*)(p.ws + WS_PROJ);
    const int dsh = 2 * br;
    const float slope = exp2f(-0.5f * (float)(h + 1));
    const float NINF = -__builtin_inff();
    bfu* attb = (bfu*)(p.ws + WS_ATTB) + (size_t)br * ((size_t)MP * 1024);
    float* lse = (float*)(p.ws + WS_LSE) + (size_t)br * (MP * 16);
#pragma unroll 1
    for (int tt = 0; tt < 2; ++tt) {
        const int kb = 16 * (wave * 2 + tt);
        const int i0 = i_start + kb;
        const int tq = r + ((i0 + l15) << dsh);
        const bf16x8 q0 = tt ? qf[2] : qf[0], q1 = tt ? qf[3] : qf[1];
        f32x4 s[9];
#pragma unroll
        for (int kt = 0; kt < 9; ++kt) {
            if (kt % 3 == 0) __builtin_amdgcn_sched_barrier(0);
            const bfu* kp = Kl + (kb + 16 * kt + l15) * 72 + quad * 8;
            f32x4 a = {0.f, 0.f, 0.f, 0.f};
            a = MFMA16(*(const bf16x8*)kp, q0, a); a = MFMA16(*(const bf16x8*)(kp + 32), q1, a);
            s[kt] = a;
        }
        const int dbase = 128 + l15 - quad * 4;
        const int dmax = (i0 + l15) < 128 ? (i0 + l15) : 128;
        const float sd = slope * (float)(1 << dsh) * 1.4426950408889634f, nb = -sd * (float)dbase;
        float mx = NINF;
#pragma unroll
        for (int kt = 0; kt < 9; ++kt)
#pragma unroll
            for (int j = 0; j < 4; ++j) {
                const int cst = 16 * kt + j;
                const float bias = __builtin_fmaf(sd, (float)cst, nb);
                float v = __builtin_fmaf(s[kt][j], 0.125f * 1.4426950408889634f, bias);
                if (kt == 0 || kt == 8 || i_start == 0) v = ((unsigned)(dbase - cst) <= (unsigned)dmax) ? v : NINF;
                s[kt][j] = v; mx = fmaxf(mx, v);
            }
        mx = fmaxf(mx, __shfl_xor(mx, 16)); mx = fmaxf(mx, __shfl_xor(mx, 32));
        float den = 0.f;
#pragma unroll
        for (int kt = 0; kt < 9; ++kt)
#pragma unroll
            for (int j = 0; j < 4; ++j) { const float e = __builtin_amdgcn_exp2f(s[kt][j] - mx); s[kt][j] = e; den += e; }
        den += __shfl_xor(den, 16); den += __shfl_xor(den, 32);
        f32x4 o[4];
#pragma unroll
        for (int dt = 0; dt < 4; ++dt) o[dt] = (f32x4){0.f, 0.f, 0.f, 0.f};
#pragma unroll
        for (int kk = 0; kk < 5; ++kk) {
            uint4 pu; pu.x = pk2(s[2 * kk][0], s[2 * kk][1]); pu.y = pk2(s[2 * kk][2], s[2 * kk][3]);
            if (kk < 4) { pu.z = pk2(s[kk < 4 ? 2 * kk + 1 : 8][0], s[kk < 4 ? 2 * kk + 1 : 8][1]); pu.w = pk2(s[kk < 4 ? 2 * kk + 1 : 8][2], s[kk < 4 ? 2 * kk + 1 : 8][3]); }
            else { pu.z = 0u; pu.w = 0u; }
            const bf16x8 pf = __builtin_bit_cast(bf16x8, pu);
#pragma unroll
            for (int dt = 0; dt < 4; ++dt) {
                const bfu* vp = Vl + (dt * 16 + l15) * 392 + kb + 32 * kk + quad * 4;
                const uint2 lo = *(const uint2*)vp;
                uint2 hi; if (kk < 4) hi = *(const uint2*)(vp + 16); else { hi.x = 0u; hi.y = 0u; }
                o[dt] = MFMA16(mk8(lo, hi), pf, o[dt]);
            }
        }
        const float inv = 1.f / den;
        const size_t row = (size_t)(b * 4096 + tq);
#pragma unroll
        for (int dt = 0; dt < 4; ++dt) {
            uint2 ov; ov.x = pk2(o[dt][0] * inv, o[dt][1] * inv); ov.y = pk2(o[dt][2] * inv, o[dt][3] * inv);
            *(uint2*)(attb + row * 1024 + h * 64 + dt * 16 + quad * 4) = ov;
        }
        if (quad == 0) lse[row * 16 + h] = (mx + __log2f(den)) * 0.6931471805599453f;
    }
}

__device__ __forceinline__ void attn_sample_unit(const Params& p, int unit, float* lds) {
    const int h = unit & 15, b = unit >> 4;
    const int tid = threadIdx.x, lane = tid & 63, wave = tid >> 6, ks = lane >> 4, d4 = lane & 15;
    float* sbuf = lds + wave * 136;
    const int row = MP + b * 8 + wave;
    const bfu* proj = (const bfu*)(p.ws + WS_PROJ);
    const uint2 qu = *(const uint2*)(proj + (size_t)row * NPROJ + h * 64 + d4 * 4);
    const float q0 = bflo(qu.x) * 0.125f, q1 = bfhi(qu.x) * 0.125f, q2 = bflo(qu.y) * 0.125f, q3 = bfhi(qu.y) * 0.125f;
    const float slope = exp2f(-0.5f * (float)(h + 1));
    const float* kc = p.cache_k + ((size_t)b * 2048 * 16 + h) * 64 + d4 * 4;
    const float* vc = p.cache_v + ((size_t)b * 2048 * 16 + h) * 64 + d4 * 4;
    const float* kn = p.out + O_KS + ((size_t)b * 8 * 16 + h) * 64 + d4 * 4;
    const float* vn = p.out + O_VS + ((size_t)b * 8 * 16 + h) * 64 + d4 * 4;
    const float NINF = -__builtin_inff();
    float mr = NINF, lr = 0.f; float4 orun = make_float4(0.f, 0.f, 0.f, 0.f);
    for (int br = 0; br < 3; ++br) {
        const int dsh = 2 * br;
#pragma unroll 1
        for (int ob = 0; ob < 2; ++ob) {
            float4 kv[17];
#pragma unroll
            for (int i = 0; i < 17; ++i) {
                const int j = (ob * 17 + i) * 4 + ks, jc = j > 128 ? 128 : j;
                const int pos = 2048 + wave - (jc << dsh);
                const float* kp = (pos < 2048) ? kc + (size_t)pos * 1024 : kn + (size_t)(pos - 2048) * 1024;
                kv[i] = *(const float4*)kp;
            }
            float pr[17];
#pragma unroll
            for (int i = 0; i < 17; ++i) pr[i] = rowsum16(q0 * kv[i].x + q1 * kv[i].y + q2 * kv[i].z + q3 * kv[i].w);
#pragma unroll
            for (int i = 0; i < 17; ++i) {
                const int j = (ob * 17 + i) * 4 + ks;
                if (d4 == 0 && j <= 128) sbuf[j] = pr[i] - slope * (float)(j << dsh);
            }
        }
        __builtin_amdgcn_wave_barrier();
        const float v0 = sbuf[lane], v1 = sbuf[lane + 64], v2 = (lane == 0) ? sbuf[128] : NINF;
        const float m = wmax(fmaxf(fmaxf(v0, v1), v2));
        const float e0 = __expf(v0 - m), e1 = __expf(v1 - m), e2 = (lane == 0) ? __expf(v2 - m) : 0.f;
        const float den = wsum(e0 + e1 + e2);
        __builtin_amdgcn_wave_barrier();
        sbuf[lane] = e0; sbuf[lane + 64] = e1; if (lane == 0) sbuf[128] = e2;
        __builtin_amdgcn_wave_barrier();
        float4 acc = make_float4(0.f, 0.f, 0.f, 0.f);
#pragma unroll 1
        for (int ob = 0; ob < 2; ++ob) {
            float4 vv[17];
#pragma unroll
            for (int i = 0; i < 17; ++i) {
                const int j = (ob * 17 + i) * 4 + ks, jc = j > 128 ? 128 : j;
                const int pos = 2048 + wave - (jc << dsh);
                const float* vp = (pos < 2048) ? vc + (size_t)pos * 1024 : vn + (size_t)(pos - 2048) * 1024;
                vv[i] = *(const float4*)vp;
            }
#pragma unroll
            for (int i = 0; i < 17; ++i) {
                const int j = (ob * 17 + i) * 4 + ks, jc = j > 128 ? 128 : j;
                const float pj = (j <= 128) ? sbuf[jc] : 0.f;
                acc.x += pj * vv[i].x; acc.y += pj * vv[i].y; acc.z += pj * vv[i].z; acc.w += pj * vv[i].w;
            }
        }
        acc.x += __shfl_xor(acc.x, 16); acc.y += __shfl_xor(acc.y, 16); acc.z += __shfl_xor(acc.z, 16); acc.w += __shfl_xor(acc.w, 16);
        acc.x += __shfl_xor(acc.x, 32); acc.y += __shfl_xor(acc.y, 32); acc.z += __shfl_xor(acc.z, 32); acc.w += __shfl_xor(acc.w, 32);
        const float mn = fmaxf(mr, m), a = __expf(mr - mn), bb = __expf(m - mn);
        orun.x = orun.x * a + acc.x * bb; orun.y = orun.y * a + acc.y * bb; orun.z = orun.z * a + acc.z * bb; orun.w = orun.w * a + acc.w * bb;
        lr = lr * a + den * bb; mr = mn;
        __builtin_amdgcn_wave_barrier();
    }
    if (ks == 0) {
        const float inv = 1.f / lr;
        uint2 o; o.x = pk2(orun.x * inv, orun.y * inv); o.y = pk2(orun.z * inv, orun.w * inv);
        *(uint2*)((bfu*)(p.ws + WS_ATT) + (size_t)row * 1024 + h * 64 + d4 * 4) = o;
    }
}

__device__ __forceinline__ void ssd_cumsum(const Params& p, int row0, int g, float* csb, float* dtb) {
    const int tid = threadIdx.x, hh = tid >> 7, l = tid & 127, h = g * 4 + hh, lane = tid & 63;
    const float dt = ((const float*)(p.ws + WS_DT))[(size_t)(row0 + l) * 16 + h];
    const float a = -__expf(p.a_log[h]);
    float v = dt * a;
#pragma unroll
    for (int off = 1; off < 64; off <<= 1) { const float t = __shfl_up(v, off); if (lane >= off) v += t; }
    dtb[tid] = dt; csb[tid] = v;
    __syncthreads();
    if (l >= 64) { v += csb[hh * 128 + 63]; }
    __syncthreads();
    csb[tid] = v;
    __syncthreads();
}

__device__ __forceinline__ void conv4x8(const Params& p, int b, int c, int l0, int ch, float (&o)[4][8]) {
    const bfu* proj = (const bfu*)(p.ws + WS_PROJ);
    bfu* xbc = (bfu*)(p.ws + WS_XBC);
    float w0[8], w1[8], w2[8], w3[8], cb[8];
    ld8f32(p.conv_w + ch, w0); ld8f32(p.conv_w + 2048 + ch, w1); ld8f32(p.conv_w + 4096 + ch, w2); ld8f32(p.conv_w + 6144 + ch, w3); ld8f32(p.conv_b + ch, cb);
    const int t0 = c * 128 + l0;
    const size_t rowb = (size_t)b * 4096;
    float r[7][8];
#pragma unroll
    for (int k = 0; k < 7; ++k) {
        const int t = t0 - 3 + k;
        ld8f(proj + (rowb + (t < 0 ? 0 : t)) * NPROJ + 4096 + ch, r[k]);
        if (k < 3) {
#pragma unroll
            for (int j = 0; j < 8; ++j) r[k][j] = (t >= 0) ? r[k][j] : 0.f;
        }
    }
#pragma unroll
    for (int k = 0; k < 4; ++k) {
#pragma unroll
        for (int j = 0; j < 8; ++j) o[k][j] = silu_f(cb[j] + w0[j] * r[k][j] + w1[j] * r[k + 1][j] + w2[j] * r[k + 2][j] + w3[j] * r[k + 3][j]);
        uint4 ov; ov.x = pk2(o[k][0], o[k][1]); ov.y = pk2(o[k][2], o[k][3]); ov.z = pk2(o[k][4], o[k][5]); ov.w = pk2(o[k][6], o[k][7]);
        *(uint4*)(xbc + (rowb + t0 + k) * 2048 + ch) = ov;
        if (t0 + k >= 4093) {
            float* dst = p.out + O_CP + ((size_t)b * 3 + (t0 + k - 4093)) * 2048 + ch;
            *(float4*)dst = make_float4(r[k + 3][0], r[k + 3][1], r[k + 3][2], r[k + 3][3]); *(float4*)(dst + 4) = make_float4(r[k + 3][4], r[k + 3][5], r[k + 3][6], r[k + 3][7]);
        }
    }
}

__device__ __forceinline__ void ssd_s1_unit(const Params& p, int unit, unsigned char* ldsb) {
    const int g = unit & 3, c = (unit >> 2) & 31, b = unit >> 7;
    const int tid = threadIdx.x, lane = tid & 63, wave = __builtin_amdgcn_readfirstlane(tid >> 6), l15 = lane & 15, quad = lane >> 4;
    bfu* BT = (bfu*)ldsb;
    bfu* XT = BT + 128 * 136;
    float* csb = (float*)(XT + 256 * 136);
    float* dtb = csb + 512;
    const int row0 = b * 4096 + c * 128;
    ssd_cumsum(p, row0, g, csb, dtb);
    {
        const int hh = tid >> 7, l = tid & 127;
        const float end = csb[hh * 128 + 127], v = csb[tid], dt = dtb[tid];
        __syncthreads();
        dtb[tid] = dt * __expf(end - v);
        if (l == 127) ((float*)(p.ws + WS_DECAY))[(b * 32 + c) * 16 + g * 4 + hh] = __expf(v);
    }
    __syncthreads();
    {
        const int cgrp = tid & 15, l0 = (tid >> 4) * 4;
        float o[4][8];
        conv4x8(p, b, c, l0, 1024 + g * 128 + cgrp * 8, o);
#pragma unroll
        for (int j = 0; j < 8; ++j) { uint2 w; w.x = pk2(o[0][j], o[1][j]); w.y = pk2(o[2][j], o[3][j]); *(uint2*)(BT + (cgrp * 8 + j) * 136 + l0) = w; }
        conv4x8(p, b, c, l0, 1536 + g * 128 + cgrp * 8, o);
    }
#pragma unroll 1
    for (int i = 0; i < 2; ++i) {
        const int e = tid + 512 * i, cg32 = e & 31, l0 = (e >> 5) * 4;
        float o[4][8];
        conv4x8(p, b, c, l0, g * 256 + cg32 * 8, o);
        const float* wl = dtb + (cg32 >> 3) * 128 + l0;
        const float wa = wl[0], wb = wl[1], wc_ = wl[2], wd = wl[3];
#pragma unroll
        for (int j = 0; j < 8; ++j) { uint2 w; w.x = pk2(o[0][j] * wa, o[1][j] * wb); w.y = pk2(o[2][j] * wc_, o[3][j] * wd); *(uint2*)(XT + (cg32 * 8 + j) * 136 + l0) = w; }
    }
    __syncthreads();
    for (int hh = 0; hh < 4; ++hh) {
        const int h = g * 4 + hh;
        const bfu* XTh = XT + hh * 64 * 136;
        f32x4 acc[4];
#pragma unroll
        for (int mt = 0; mt < 4; ++mt) acc[mt] = (f32x4){0.f, 0.f, 0.f, 0.f};
#pragma unroll
        for (int ks = 0; ks < 4; ++ks) {
            const bf16x8 bfr = *(const bf16x8*)(BT + (wave * 16 + l15) * 136 + ks * 32 + quad * 8);
#pragma unroll
            for (int mt = 0; mt < 4; ++mt) { const bf16x8 afr = *(const bf16x8*)(XTh + (mt * 16 + l15) * 136 + ks * 32 + quad * 8); acc[mt] = MFMA16(bfr, afr, acc[mt]); }
        }
        bfu* st = (bfu*)(p.ws + WS_STATES) + ((size_t)((b * 32 + c) * 16 + h) * 64) * 128;
#pragma unroll
        for (int mt = 0; mt < 4; ++mt) { uint2 o; o.x = pk2(acc[mt][0], acc[mt][1]); o.y = pk2(acc[mt][2], acc[mt][3]); *(uint2*)(st + (mt * 16 + l15) * 128 + wave * 16 + quad * 4) = o; }
    }
    __syncthreads();
}

__device__ __forceinline__ void ssd_s3_unit(const Params& p, int unit, unsigned char* ldsb) {
    const int g = unit & 3, c = (unit >> 2) & 31, b = unit >> 7;
    const int tid = threadIdx.x, lane = tid & 63, wave = __builtin_amdgcn_readfirstlane(tid >> 6), l15 = lane & 15, quad = lane >> 4;
    bfu* Cs = (bfu*)ldsb;
    bfu* Bs = Cs + 128 * 136;
    bfu* XT4 = Bs + 128 * 136;
    float* csb = (float*)(XT4 + 256 * 136);
    float* dtb = csb + 512;
    const int row0 = b * 4096 + c * 128;
    const bfu* xbc = (const bfu*)(p.ws + WS_XBC);
    const bfu* proj = (const bfu*)(p.ws + WS_PROJ);
    ssd_cumsum(p, row0, g, csb, dtb);
#pragma unroll
    for (int i = 0; i < 4; ++i) {
        const int e = tid + 512 * i, l = e >> 4, n8 = (e & 15) * 8;
        *(uint4*)(Bs + l * 136 + n8) = *(const uint4*)(xbc + (size_t)(row0 + l) * 2048 + 1024 + g * 128 + n8);
        *(uint4*)(Cs + l * 136 + n8) = *(const uint4*)(xbc + (size_t)(row0 + l) * 2048 + 1536 + g * 128 + n8);
    }
#pragma unroll
    for (int i = 0; i < 8; ++i) {
        const int e = tid + 512 * i, l = e & 127, p8 = (e >> 7) * 8;
        const uint4 v = *(const uint4*)(xbc + (size_t)(row0 + l) * 2048 + g * 256 + p8);
        bfu* tp = XT4 + p8 * 136 + l;
        tp[0] = (bfu)(v.x & 0xffff); tp[136] = (bfu)(v.x >> 16); tp[2 * 136] = (bfu)(v.y & 0xffff); tp[3 * 136] = (bfu)(v.y >> 16);
        tp[4 * 136] = (bfu)(v.z & 0xffff); tp[5 * 136] = (bfu)(v.z >> 16); tp[6 * 136] = (bfu)(v.w & 0xffff); tp[7 * 136] = (bfu)(v.w >> 16);
    }
    __syncthreads();
    f32x4 cbt[8];
#pragma unroll
    for (int st = 0; st < 8; ++st) {
        f32x4 a = {0.f, 0.f, 0.f, 0.f};
        if (st <= wave) {
#pragma unroll
            for (int ks = 0; ks < 4; ++ks)
                a = MFMA16(*(const bf16x8*)(Bs + (st * 16 + l15) * 136 + ks * 32 + quad * 8), *(const bf16x8*)(Cs + (wave * 16 + l15) * 136 + ks * 32 + quad * 8), a);
        }
        cbt[st] = a;
    }
    const int lrow = wave * 16 + l15;
    for (int hh = 0; hh < 4; ++hh) {
        const int h = g * 4 + hh;
        const bfu* XT = XT4 + hh * 64 * 136;
        const float csl = csb[hh * 128 + lrow];
        f32x4 acc[4];
#pragma unroll
        for (int mt = 0; mt < 4; ++mt) acc[mt] = (f32x4){0.f, 0.f, 0.f, 0.f};
        const bfu* hp = (const bfu*)(p.ws + WS_HPREV) + ((size_t)((b * 32 + c) * 16 + h) * 64) * 128;
        bf16x8 hf[16];
#pragma unroll
        for (int i = 0; i < 16; ++i) hf[i] = ld8g(hp + (size_t)((i & 3) * 16 + l15) * 128 + (i >> 2) * 32 + quad * 8);
        __builtin_amdgcn_sched_barrier(0);
#pragma unroll
        for (int ks = 0; ks < 4; ++ks) {
            const bf16x8 bfr = *(const bf16x8*)(Cs + lrow * 136 + ks * 32 + quad * 8);
#pragma unroll
            for (int mt = 0; mt < 4; ++mt) acc[mt] = MFMA16(hf[ks * 4 + mt], bfr, acc[mt]);
        }
        const float el = __expf(csl);
#pragma unroll
        for (int mt = 0; mt < 4; ++mt) { acc[mt][0] *= el; acc[mt][1] *= el; acc[mt][2] *= el; acc[mt][3] *= el; }
#pragma unroll
        for (int kk = 0; kk < 4; ++kk) {
            if (2 * kk <= wave) {
                float mv[8];
#pragma unroll
                for (int j = 0; j < 8; ++j) {
                    const int tile = 2 * kk + (j >> 2), s = tile * 16 + quad * 4 + (j & 3);
                    const float cbv = cbt[tile][j & 3];
                    const float e = __expf(csl - csb[hh * 128 + s]) * dtb[hh * 128 + s];
                    mv[j] = (s <= lrow) ? cbv * e : 0.f;
                }
                uint4 pu; pu.x = pk2(mv[0], mv[1]); pu.y = pk2(mv[2], mv[3]); pu.z = pk2(mv[4], mv[5]); pu.w = pk2(mv[6], mv[7]);
                const bf16x8 pf = __builtin_bit_cast(bf16x8, pu);
#pragma unroll
                for (int mt = 0; mt < 4; ++mt) {
                    const bfu* xp = XT + (mt * 16 + l15) * 136 + 32 * kk + quad * 4;
                    acc[mt] = MFMA16(mk8(*(const uint2*)xp, *(const uint2*)(xp + 16)), pf, acc[mt]);
                }
            }
        }
        const float dsk = p.d_skip[h];
        const size_t row = (size_t)(row0 + lrow);
        bfu* yg = (bfu*)(p.ws + WS_YG);
#pragma unroll
        for (int mt = 0; mt < 4; ++mt) {
            const int pc = h * 64 + mt * 16 + quad * 4;
            const uint2 xu = *(const uint2*)(xbc + row * 2048 + pc);
            const uint2 zu = *(const uint2*)(proj + row * NPROJ + 3072 + pc);
            const float y0 = (acc[mt][0] + dsk * bflo(xu.x)) * silu_f(bflo(zu.x)), y1 = (acc[mt][1] + dsk * bfhi(xu.x)) * silu_f(bfhi(zu.x));
            const float y2 = (acc[mt][2] + dsk * bflo(xu.y)) * silu_f(bflo(zu.y)), y3 = (acc[mt][3] + dsk * bfhi(xu.y)) * silu_f(bfhi(zu.y));
            uint2 o; o.x = pk2(y0, y1); o.y = pk2(y2, y3);
            *(uint2*)(yg + row * 1024 + pc) = o;
        }
    }
    __syncthreads();
}

__device__ __forceinline__ void ssd_sample_unit(const Params& p, int unit, float* lds) {
    const int h = unit & 15, b = unit >> 4, g = h >> 2, tid = threadIdx.x;
    float* Bf = lds; float* Cf = Bf + 1024; float* xsf = Cf + 1024; float* cbm = xsf + 512; float* csb = cbm + 64; float* dtb = csb + 8;
    const int row0 = MP + b * 8;
    const bfu* xbc = (const bfu*)(p.ws + WS_XBC);
    const bfu* proj = (const bfu*)(p.ws + WS_PROJ);
    {
        const int l = tid >> 6, n2 = (tid & 63) * 2;
        const unsigned ub = *(const unsigned*)(xbc + (size_t)(row0 + l) * 2048 + 1024 + g * 128 + n2);
        const unsigned uc = *(const unsigned*)(xbc + (size_t)(row0 + l) * 2048 + 1536 + g * 128 + n2);
        Bf[l * 128 + n2] = bflo(ub); Bf[l * 128 + n2 + 1] = bfhi(ub); Cf[l * 128 + n2] = bflo(uc); Cf[l * 128 + n2 + 1] = bfhi(uc);
        xsf[tid] = bf2f(xbc[(size_t)(row0 + l) * 2048 + h * 64 + (tid & 63)]);
        if (tid < 8) dtb[tid] = ((const float*)(p.ws + WS_DT))[(size_t)(row0 + tid) * 16 + h];
    }
    __syncthreads();
    if (tid == 0) { const float a = -__expf(p.a_log[h]); float run = 0.f; for (int l = 0; l < 8; ++l) { run += dtb[l] * a; csb[l] = run; } }
    __syncthreads();
    if (tid < 64) {
        const int l = tid >> 3, s = tid & 7;
        float d = 0.f;
        if (s <= l) { for (int n = 0; n < 128; ++n) d += Cf[l * 128 + n] * Bf[s * 128 + n]; d *= __expf(csb[l] - csb[s]) * dtb[s]; }
        cbm[tid] = d;
    }
    __syncthreads();
    const int pp = tid >> 3, nn = tid & 7;
    const size_t soff = ((size_t)(b * 16 + h) * 64 + pp) * 128 + nn * 16;
    const float* hp = p.state_ssm + soff;
    float4 h0 = *(const float4*)hp, h1 = *(const float4*)(hp + 4), h2 = *(const float4*)(hp + 8), h3 = *(const float4*)(hp + 12);
    float myoff = 0.f;
#pragma unroll
    for (int l = 0; l < 8; ++l) {
        const float* cp = Cf + l * 128 + nn * 16;
        float part = cp[0] * h0.x + cp[1] * h0.y + cp[2] * h0.z + cp[3] * h0.w + cp[4] * h1.x + cp[5] * h1.y + cp[6] * h1.z + cp[7] * h1.w
                   + cp[8] * h2.x + cp[9] * h2.y + cp[10] * h2.z + cp[11] * h2.w + cp[12] * h3.x + cp[13] * h3.y + cp[14] * h3.z + cp[15] * h3.w;
        part += __shfl_xor(part, 1); part += __shfl_xor(part, 2); part += __shfl_xor(part, 4);
        if (nn == l) myoff = part;
    }
    const float cs7 = csb[7], e7 = __expf(cs7);
    h0.x *= e7; h0.y *= e7; h0.z *= e7; h0.w *= e7; h1.x *= e7; h1.y *= e7; h1.z *= e7; h1.w *= e7;
    h2.x *= e7; h2.y *= e7; h2.z *= e7; h2.w *= e7; h3.x *= e7; h3.y *= e7; h3.z *= e7; h3.w *= e7;
#pragma unroll
    for (int l = 0; l < 8; ++l) {
        const float w = __expf(cs7 - csb[l]) * dtb[l] * xsf[l * 64 + pp];
        const float* bp = Bf + l * 128 + nn * 16;
        h0.x += bp[0] * w; h0.y += bp[1] * w; h0.z += bp[2] * w; h0.w += bp[3] * w; h1.x += bp[4] * w; h1.y += bp[5] * w; h1.z += bp[6] * w; h1.w += bp[7] * w;
        h2.x += bp[8] * w; h2.y += bp[9] * w; h2.z += bp[10] * w; h2.w += bp[11] * w; h3.x += bp[12] * w; h3.y += bp[13] * w; h3.z += bp[14] * w; h3.w += bp[15] * w;
    }
    float* so = p.out + O_SS + soff;
    *(float4*)so = h0; *(float4*)(so + 4) = h1; *(float4*)(so + 8) = h2; *(float4*)(so + 12) = h3;
    {
        const int l = nn;
        float y = myoff * __expf(csb[l]);
#pragma unroll
        for (int s = 0; s < 8; ++s) y += cbm[l * 8 + s] * xsf[s * 64 + pp];
        y += p.d_skip[h] * xsf[l * 64 + pp];
        const float z = bf2f(proj[(size_t)(row0 + l) * NPROJ + 3072 + h * 64 + pp]);
        ((bfu*)(p.ws + WS_YG))[(size_t)(row0 + l) * 1024 + h * 64 + pp] = (bfu)f2bf(y * silu_f(z));
    }
    __syncthreads();
}

__device__ __forceinline__ void phase3(const Params& p, unsigned char* lds, int bid, int G) {
    {
        const bool xa = (G == 256);
        const int x = bid & 7, sl = bid >> 3;
        const int nun = xa ? 12 : (3072 - bid + G - 1) / G;
#define ATTN_UNIT_OF(i, U) { const int v_ = xa ? sl + 32 * (i) : bid + G * (i), rest_ = v_ % 48; U = attn_decode(xa ? x + 8 * (v_ / 48) : v_ / 48, rest_ >> 4, rest_ & 15); }
        for (int i = 0; i < nun; ++i) {
            AttnUnit uc; ATTN_UNIT_OF(i, uc);
            bf16x8 qf[4]; attn_qload(p, uc, qf);
            { uint4 sk_[6], sv_[6]; attn_stage_load(p, uc, sk_, sv_); attn_stage_store(sk_, sv_, lds); }
            __syncthreads();
            attn_compute(p, uc, lds, qf);
            __syncthreads();
        }
#undef ATTN_UNIT_OF
    }
    for (int u = bid; u < 512; u += G) attn_sample_unit(p, u, (float*)lds);
    __syncthreads();
    for (int u = bid; u < 512; u += G) ssd_s1_unit(p, u, lds);
    for (int u = bid; u < 512; u += G) ssd_sample_unit(p, u, (float*)lds);
}

__device__ __forceinline__ void phase4_scan(const Params& p, int bid, int G) {
    const bfu* states = (const bfu*)(p.ws + WS_STATES);
    const float* decay = (const float*)(p.ws + WS_DECAY);
    bfu* hprev = (bfu*)(p.ws + WS_HPREV);
    for (int i = bid * 512 + threadIdx.x; i < 131072; i += G * 512) {
        const int e = i * 4, n = e & 127, pp = (e >> 7) & 63, h = (e >> 13) & 15, b = e >> 17;
        float4 hc = make_float4(0.f, 0.f, 0.f, 0.f);
#pragma unroll 16
        for (int c = 0; c < 32; ++c) {
            const float dec = decay[(b * 32 + c) * 16 + h];
            const size_t off = ((size_t)((b * 32 + c) * 16 + h) * 64 + pp) * 128 + n;
            const uint2 su = *(const uint2*)(states + off);
            const float4 st = make_float4(bflo(su.x), bfhi(su.x), bflo(su.y), bfhi(su.y));
            uint2 o; o.x = pk2(hc.x, hc.y); o.y = pk2(hc.z, hc.w);
            *(uint2*)(hprev + off) = o;
            hc.x = hc.x * dec + st.x; hc.y = hc.y * dec + st.y; hc.z = hc.z * dec + st.z; hc.w = hc.w * dec + st.w;
        }
        *(float4*)(p.out + O_SP + ((size_t)(b * 16 + h) * 64 + pp) * 128 + n) = hc;
    }
}

__device__ __forceinline__ void rms_half(const bfu* src, const float* gam, bfu* dst, int lane) {
    float a[8], c[8];
    ld8f(src + lane * 8, a); ld8f(src + 512 + lane * 8, c);
    float ss = 0.f;
#pragma unroll
    for (int j = 0; j < 8; ++j) ss += a[j] * a[j] + c[j] * c[j];
    ss = wsum(ss);
    const float rs = rsqrtf(ss * (1.f / 1024.f) + EPS);
    float g0[8], g1[8]; ld8f32(gam + lane * 8, g0); ld8f32(gam + 512 + lane * 8, g1);
    uint4 o0, o1;
    o0.x = pk2(a[0] * rs * g0[0], a[1] * rs * g0[1]); o0.y = pk2(a[2] * rs * g0[2], a[3] * rs * g0[3]); o0.z = pk2(a[4] * rs * g0[4], a[5] * rs * g0[5]); o0.w = pk2(a[6] * rs * g0[6], a[7] * rs * g0[7]);
    o1.x = pk2(c[0] * rs * g1[0], c[1] * rs * g1[1]); o1.y = pk2(c[2] * rs * g1[2], c[3] * rs * g1[3]); o1.z = pk2(c[4] * rs * g1[4], c[5] * rs * g1[5]); o1.w = pk2(c[6] * rs * g1[6], c[7] * rs * g1[7]);
    *(uint4*)(dst + lane * 8) = o0; *(uint4*)(dst + 512 + lane * 8) = o1;
}
__device__ __forceinline__ void attn_merge_rms(const Params& p, int row, bfu* dst, int lane) {
    const bfu* attb = (const bfu*)(p.ws + WS_ATTB); const float* lse = (const float*)(p.ws + WS_LSE);
    float a[8], c[8];
#pragma unroll
    for (int j = 0; j < 8; ++j) { a[j] = 0.f; c[j] = 0.f; }
    const int h0 = lane >> 3, h1 = 8 + (lane >> 3);
    float l0[3], l1[3];
#pragma unroll
    for (int br = 0; br < 3; ++br) { l0[br] = lse[(size_t)br * (MP * 16) + (size_t)row * 16 + h0]; l1[br] = lse[(size_t)br * (MP * 16) + (size_t)row * 16 + h1]; }
    const float m0 = fmaxf(fmaxf(l0[0], l0[1]), l0[2]), m1 = fmaxf(fmaxf(l1[0], l1[1]), l1[2]);
    float w0[3], w1[3];
#pragma unroll
    for (int br = 0; br < 3; ++br) { w0[br] = __expf(l0[br] - m0); w1[br] = __expf(l1[br] - m1); }
    const float i0 = 1.f / (w0[0] + w0[1] + w0[2]), i1 = 1.f / (w1[0] + w1[1] + w1[2]);
#pragma unroll
    for (int br = 0; br < 3; ++br) {
        float x[8], y[8];
        const bfu* src = attb + (size_t)br * ((size_t)MP * 1024) + (size_t)row * 1024;
        ld8f(src + lane * 8, x); ld8f(src + 512 + lane * 8, y);
        const float f0 = w0[br] * i0, f1 = w1[br] * i1;
#pragma unroll
        for (int j = 0; j < 8; ++j) { a[j] += f0 * x[j]; c[j] += f1 * y[j]; }
    }
    float ss = 0.f;
#pragma unroll
    for (int j = 0; j < 8; ++j) ss += a[j] * a[j] + c[j] * c[j];
    ss = wsum(ss);
    const float rs = rsqrtf(ss * (1.f / 1024.f) + EPS);
    const float* gam = p.attn_g;
    float g0[8], g1[8]; ld8f32(gam + lane * 8, g0); ld8f32(gam + 512 + lane * 8, g1);
    uint4 o0, o1;
    o0.x = pk2(a[0] * rs * g0[0], a[1] * rs * g0[1]); o0.y = pk2(a[2] * rs * g0[2], a[3] * rs * g0[3]); o0.z = pk2(a[4] * rs * g0[4], a[5] * rs * g0[5]); o0.w = pk2(a[6] * rs * g0[6], a[7] * rs * g0[7]);
    o1.x = pk2(c[0] * rs * g1[0], c[1] * rs * g1[1]); o1.y = pk2(c[2] * rs * g1[2], c[3] * rs * g1[3]); o1.z = pk2(c[4] * rs * g1[4], c[5] * rs * g1[5]); o1.w = pk2(c[6] * rs * g1[6], c[7] * rs * g1[7]);
    *(uint4*)(dst + lane * 8) = o0; *(uint4*)(dst + 512 + lane * 8) = o1;
}
__device__ __forceinline__ void phase6(const Params& p, int bid, int G) {
    const int lane = threadIdx.x & 63, wave = threadIdx.x >> 6;
    const bfu* att = (const bfu*)(p.ws + WS_ATT); const bfu* yg = (const bfu*)(p.ws + WS_YG); bfu* mix = (bfu*)(p.ws + WS_MIX);
    for (int row = bid * 8 + wave; row < MT; row += G * 8) {
        if (row < MP) attn_merge_rms(p, row, mix + (size_t)row * 2048, lane);
        else rms_half(att + (size_t)row * 1024, p.attn_g, mix + (size_t)row * 2048, lane);
        rms_half(yg + (size_t)row * 1024, p.ssm_g, mix + (size_t)row * 2048 + 1024, lane);
    }
}
__device__ __forceinline__ void ln_phase(const float* pre, const float* gam, const float* bet, float* of32, bfu* obf, int bid, int G) {
    const int lane = threadIdx.x & 63, wave = threadIdx.x >> 6;
    for (int row = bid * 8 + wave; row < MT; row += G * 8) {
        const float* pr = pre + (size_t)row * 1024;
        float4 v[4];
        float s = 0.f;
#pragma unroll
        for (int i = 0; i < 4; ++i) { v[i] = *(const float4*)(pr + i * 256 + lane * 4); s += v[i].x + v[i].y + v[i].z + v[i].w; }
        const float mu = wsum(s) * (1.f / 1024.f);
        float q = 0.f;
#pragma unroll
        for (int i = 0; i < 4; ++i) { v[i].x -= mu; v[i].y -= mu; v[i].z -= mu; v[i].w -= mu; q += v[i].x * v[i].x + v[i].y * v[i].y + v[i].z * v[i].z + v[i].w * v[i].w; }
        const float rs = rsqrtf(wsum(q) * (1.f / 1024.f) + EPS);
#pragma unroll
        for (int i = 0; i < 4; ++i) {
            const int c = i * 256 + lane * 4;
            const float4 gg = *(const float4*)(gam + c), bb = *(const float4*)(bet + c);
            const float4 y = make_float4(v[i].x * rs * gg.x + bb.x, v[i].y * rs * gg.y + bb.y, v[i].z * rs * gg.z + bb.z, v[i].w * rs * gg.w + bb.w);
            if (of32) *(float4*)(of32 + (size_t)row * 1024 + c) = y;
            if (obf) { uint2 o; o.x = pk2(y.x, y.y); o.y = pk2(y.z, y.w); *(uint2*)(obf + (size_t)row * 1024 + c) = o; }
        }
    }
}


template <int K>
__device__ __forceinline__ void skinny_sample_gemm(const bfu* __restrict__ A, const bfu* __restrict__ Bt, const float* __restrict__ res, float* __restrict__ pre, float* ldsf, int bid) {
    const int tid = threadIdx.x, lane = tid & 63, wave = __builtin_amdgcn_readfirstlane(tid >> 6), l15 = lane & 15, quad = lane >> 4;
    const int rg = bid >> 4, cg = bid & 15;
    constexpr int KW = K / 8, NS = KW / 32;
    const bfu* ap = A + (size_t)(MP + rg * 16 + l15) * K + wave * KW + quad * 8;
    const bfu* bp = Bt + (size_t)(cg * 64 + l15) * K + wave * KW + quad * 8;
    f32x4 acc[4];
#pragma unroll
    for (int nt = 0; nt < 4; ++nt) acc[nt] = (f32x4){0.f, 0.f, 0.f, 0.f};
#pragma unroll
    for (int ks = 0; ks < NS; ++ks) {
        const bf16x8 af = ld8g(ap + ks * 32);
#pragma unroll
        for (int nt = 0; nt < 4; ++nt) acc[nt] = MFMA16(af, ld8g(bp + (size_t)nt * 16 * K + ks * 32), acc[nt]);
    }
#pragma unroll
    for (int nt = 0; nt < 4; ++nt)
#pragma unroll
        for (int j = 0; j < 4; ++j) ldsf[wave * 1024 + (quad * 4 + j) * 64 + nt * 16 + l15] = acc[nt][j];
    __syncthreads();
#pragma unroll
    for (int i = 0; i < 2; ++i) {
        const int e = tid + 512 * i, r = e >> 6, c = e & 63;
        float v = 0.f;
#pragma unroll
        for (int w = 0; w < 8; ++w) v += ldsf[w * 1024 + e];
        const size_t row = (size_t)(rg * 16 + r);
        pre[(MP + row) * 1024 + cg * 64 + c] = v + ALPHA * res[row * 1024 + cg * 64 + c];
    }
    __syncthreads();
}

template <bool RES_BF16>
struct EpiLn {
    static constexpr bool PERM = true, AFTER_DRAIN = true;
    const void* res; const float* gam; const float* bet; float* of32; bfu* obf;
    unsigned long long* xch;
    unsigned* cnt;
    unsigned* bar;
    __device__ __forceinline__ void operator()(const f32x4 (&)[2][2][4][2], const Unit&, int, int, int, int) const {}
    __device__ __forceinline__ void fused(f32x4 (&acc)[2][2][4][2], const Unit& u, int wr, int wc, int fr, int fq, PG8_LAS unsigned char* lds, int wid, int lane) const {
        PG8_LAS float* P = (PG8_LAS float*)lds;
        PG8_LAS float* S = (PG8_LAS float*)(lds + 8192);
        const int tid = threadIdx.x;
#pragma unroll
        for (int ai = 0; ai < 2; ++ai)
#pragma unroll
            for (int m = 0; m < 4; ++m) {
                const int rl = ai * 128 + wr * 64 + m * 16 + fr;
                const size_t roff = (size_t)(u.pm * 256 + rl) * 1024 + u.pn * 256 + wc * 32 + fq * 8;
                float s1 = 0.f, s2 = 0.f;
#pragma unroll
                for (int bj = 0; bj < 2; ++bj) {
                    float x[8];
                    if (RES_BF16) ld8f((const bfu*)res + roff + bj * 128, x);
                    else ld8f32((const float*)res + roff + bj * 128, x);
#pragma unroll
                    for (int n = 0; n < 2; ++n) {
                        f32x4 v = acc[ai][bj][m][n];
                        v[0] += ALPHA * x[4 * n]; v[1] += ALPHA * x[4 * n + 1]; v[2] += ALPHA * x[4 * n + 2]; v[3] += ALPHA * x[4 * n + 3];
                        acc[ai][bj][m][n] = v;
                        s1 += (v[0] + v[1]) + (v[2] + v[3]); s2 += (v[0] * v[0] + v[1] * v[1]) + (v[2] * v[2] + v[3] * v[3]);
                    }
                }
                s1 += __shfl_xor(s1, 16); s1 += __shfl_xor(s1, 32); s2 += __shfl_xor(s2, 16); s2 += __shfl_xor(s2, 32);
                if (fq == 0) { P[(rl * 4 + wc) * 2] = s1; P[(rl * 4 + wc) * 2 + 1] = s2; }
            }
        __syncthreads();
        if (tid < 256) {
            const float a = P[tid * 8] + P[tid * 8 + 2] + P[tid * 8 + 4] + P[tid * 8 + 6], b = P[tid * 8 + 1] + P[tid * 8 + 3] + P[tid * 8 + 5] + P[tid * 8 + 7];
            const unsigned long long pk = (unsigned long long)__float_as_uint(a) | ((unsigned long long)__float_as_uint(b) << 32);
            __hip_atomic_store(xch + ((size_t)(u.pm * 256 + tid) * 4 + u.pn), pk, __ATOMIC_RELAXED, __HIP_MEMORY_SCOPE_AGENT);
        }
        asm volatile("s_waitcnt vmcnt(0)" ::: "memory");
        __syncthreads();
        if (tid == 0) {
            __builtin_amdgcn_fence(__ATOMIC_RELEASE, "agent");
            asm volatile("s_waitcnt vmcnt(0)" ::: "memory");
            unsigned* c = cnt + u.pm * 64;
            xb_add(c, 1u);
            XB_SPIN(xb_ld(c) < 4u, bar);
            __builtin_amdgcn_fence(__ATOMIC_ACQUIRE, "agent");
            asm volatile("s_waitcnt vmcnt(0)" ::: "memory");
        }
        __syncthreads();
        if (tid < 256) {
            float a = 0.f, b = 0.f;
#pragma unroll
            for (int t = 0; t < 4; ++t) {
                const unsigned long long pk = __hip_atomic_load(xch + ((size_t)(u.pm * 256 + tid) * 4 + t), __ATOMIC_RELAXED, __HIP_MEMORY_SCOPE_AGENT);
                a += __uint_as_float((unsigned)pk); b += __uint_as_float((unsigned)(pk >> 32));
            }
            const float mu = a * (1.f / 1024.f), var = fmaxf(b * (1.f / 1024.f) - mu * mu, 0.f);
            S[tid * 2] = mu; S[tid * 2 + 1] = rsqrtf(var + EPS);
        }
        __syncthreads();
#pragma unroll
        for (int bj = 0; bj < 2; ++bj) {
            const int col = u.pn * 256 + bj * 128 + wc * 32 + fq * 8;
            float gg[8], bb[8]; ld8f32(gam + col, gg); ld8f32(bet + col, bb);
#pragma unroll
            for (int ai = 0; ai < 2; ++ai)
#pragma unroll
                for (int m = 0; m < 4; ++m) {
                    const int rl = ai * 128 + wr * 64 + m * 16 + fr;
                    const float mu = S[rl * 2], rs = S[rl * 2 + 1];
                    const f32x4 v0 = acc[ai][bj][m][0], v1 = acc[ai][bj][m][1];
                    float y[8];
#pragma unroll
                    for (int j = 0; j < 4; ++j) { y[j] = (v0[j] - mu) * rs * gg[j] + bb[j]; y[4 + j] = (v1[j] - mu) * rs * gg[4 + j] + bb[4 + j]; }
                    const size_t off = (size_t)(u.pm * 256 + rl) * 1024 + col;
                    if (of32) { const f32x4 ya = {y[0], y[1], y[2], y[3]}, yb = {y[4], y[5], y[6], y[7]}; __builtin_nontemporal_store(ya, (f32x4*)(of32 + off)); __builtin_nontemporal_store(yb, (f32x4*)(of32 + off + 4)); }
                    if (obf) { uint4 o; o.x = pk2(y[0], y[1]); o.y = pk2(y[2], y[3]); o.z = pk2(y[4], y[5]); o.w = pk2(y[6], y[7]); *(uint4*)(obf + off) = o; }
                }
        }
    }
};
__device__ __forceinline__ void sample_rows_publish(unsigned* cnt_s, int bid) {
    asm volatile("s_waitcnt vmcnt(0)" ::: "memory");
    __syncthreads();
    if (threadIdx.x == 0) { __builtin_amdgcn_fence(__ATOMIC_RELEASE, "agent"); asm volatile("s_waitcnt vmcnt(0)" ::: "memory"); xb_add(cnt_s + (bid >> 4) * 64, 1u); }
}
__device__ __forceinline__ void sample_rows_ln(unsigned* cnt_s, unsigned* bar, const float* pre, const float* gam, const float* bet, float* of32, bfu* obf, int bid) {
    if (bid >= 32) return;
    if (threadIdx.x == 0) {
        unsigned* c = cnt_s + (bid >> 1) * 64;
        XB_SPIN(xb_ld(c) < 16u, bar);
        __builtin_amdgcn_fence(__ATOMIC_ACQUIRE, "agent");
        asm volatile("s_waitcnt vmcnt(0)" ::: "memory");
    }
    __syncthreads();
    const int lane = threadIdx.x & 63, wave = threadIdx.x >> 6, row = MP + bid * 8 + wave;
    const float* pr = pre + (size_t)row * 1024;
    float4 v[4];
    float s = 0.f;
#pragma unroll
    for (int i = 0; i < 4; ++i) { v[i] = *(const float4*)(pr + i * 256 + lane * 4); s += v[i].x + v[i].y + v[i].z + v[i].w; }
    const float mu = wsum(s) * (1.f / 1024.f);
    float q = 0.f;
#pragma unroll
    for (int i = 0; i < 4; ++i) { v[i].x -= mu; v[i].y -= mu; v[i].z -= mu; v[i].w -= mu; q += v[i].x * v[i].x + v[i].y * v[i].y + v[i].z * v[i].z + v[i].w * v[i].w; }
    const float rs = rsqrtf(wsum(q) * (1.f / 1024.f) + EPS);
#pragma unroll
    for (int i = 0; i < 4; ++i) {
        const int c = i * 256 + lane * 4;
        const float4 gg = *(const float4*)(gam + c), bb = *(const float4*)(bet + c);
        const float4 y = make_float4(v[i].x * rs * gg.x + bb.x, v[i].y * rs * gg.y + bb.y, v[i].z * rs * gg.z + bb.z, v[i].w * rs * gg.w + bb.w);
        if (of32) *(float4*)(of32 + (size_t)row * 1024 + c) = y;
        if (obf) { uint2 o; o.x = pk2(y.x, y.y); o.y = pk2(y.z, y.w); *(uint2*)(obf + (size_t)row * 1024 + c) = o; }
    }
}

constexpr int LDS_BYTES = 147456;
__device__ __forceinline__ const Params& kparams() {
    unsigned long long k = (unsigned long long)__builtin_amdgcn_kernarg_segment_ptr();
    asm volatile("" : "+s"(k));
#if defined(__HIP_DEVICE_COMPILE__)
    return *(const Params*)(const __attribute__((address_space(4))) Params*)k;
#else
    return *(const Params*)k;
#endif
}
#define KP (kparams())
__global__ void __launch_bounds__(512) fwd_kernel(Params p_unused) {
    extern __shared__ __attribute__((aligned(16))) unsigned char smem[];
    cg::grid_group grid = cg::this_grid();
    const int G = gridDim.x, bid = blockIdx.x;
    unsigned char* ws = KP.ws;
    PG8_LAS unsigned char* lds3 = (PG8_LAS unsigned char*)smem;

    unsigned* barw = (unsigned*)(ws + WS_BAR);
    volatile LAS unsigned* xst = (volatile LAS unsigned*)(lds3 + (LDS_BYTES - 64));
    if (bid == 0) for (int i = threadIdx.x; i < CTL_WORDS; i += 512) barw[i] = 0u;
    if (threadIdx.x < 4) xst[threadIdx.x] = 0u;
    phase0(KP, (float*)smem, bid, G);
    grid.sync();
    const XcdBarrier xb = xcd_barrier_post(barw, xst);
    {
        pg8::Gemm g{(const pg8::bf16_t*)(ws + WS_XB), (const pg8::bf16_t*)(ws + WS_WIN), MT, NPROJ, 1024};
        pg8::StaticOrder S; S.init(MT, NPROJ, G, bid);
        EpiIn E{(bfu*)(ws + WS_PROJ), KP.out};
        pg8::gemm_phase<EpiIn, pg8::StaticOrder, true, true>(lds3, g, S, E);
        after_p1_filler(KP, (float*)smem, bid, G);
    }
    xcd_barrier(xb);
    phase2(KP, smem, bid, G);
    xcd_barrier(xb);
    phase3(KP, smem, bid, G);
    xcd_barrier(xb);
    phase4_scan(KP, bid, G);
    xcd_barrier(xb);
    for (int u = bid; u < 512; u += G) ssd_s3_unit(KP, u, smem);
    xcd_barrier(xb);
    phase6(KP, bid, G);
    xcd_barrier(xb);
    unsigned* cnt_panel = barw + 4096;
    unsigned* cnt_rows = barw + 4096 + 2 * 64 * 64;
    unsigned long long* xch = (unsigned long long*)(ws + WS_XCH);
    if (G == 256) {
        {
            skinny_sample_gemm<2048>((const bfu*)(ws + WS_MIX), (const bfu*)(ws + WS_WOUT), KP.x_sample, (float*)(ws + WS_PRE), (float*)smem, bid);
            sample_rows_publish(cnt_rows, bid);
            pg8::Gemm g{(const pg8::bf16_t*)(ws + WS_MIX), (const pg8::bf16_t*)(ws + WS_WOUT), MP, 1024, 2048};
            pg8::StaticOrder S; S.init(MP, 1024, G, bid);
            EpiLn<true> E{(const bfu*)(ws + WS_XB), KP.ln1_g, KP.ln1_b, nullptr, (bfu*)(ws + WS_HDNB), xch, cnt_panel, barw};
            pg8::gemm_phase<EpiLn<true>, pg8::StaticOrder, false, true>(lds3, g, S, E);
            sample_rows_ln(cnt_rows, barw, (const float*)(ws + WS_PRE), KP.ln1_g, KP.ln1_b, (float*)(ws + WS_HDN), (bfu*)(ws + WS_HDNB), bid);
        }
        xcd_barrier(xb);
        {
            pg8::Gemm g{(const pg8::bf16_t*)(ws + WS_HDNB), (const pg8::bf16_t*)(ws + WS_WGU), MT, 2 * DFF, 1024};
            pg8::StaticOrder S; S.init(MT, 2 * DFF, G, bid);
            EpiGU E{(bfu*)(ws + WS_ACT)};
            pg8::gemm_phase<EpiGU, pg8::StaticOrder, true, true>(lds3, g, S, E);
            after_p9_filler(KP, (float*)smem, bid, G);
        }
        xcd_barrier(xb);
        {
            skinny_sample_gemm<DFF>((const bfu*)(ws + WS_ACT), (const bfu*)(ws + WS_WDN), (const float*)(ws + WS_HDN) + (size_t)MP * 1024, (float*)(ws + WS_PRE), (float*)smem, bid);
            sample_rows_publish(cnt_rows + 16 * 64, bid);
            pg8::Gemm g{(const pg8::bf16_t*)(ws + WS_ACT), (const pg8::bf16_t*)(ws + WS_WDN), MP, 1024, DFF};
            pg8::StaticOrder S; S.init(MP, 1024, G, bid);
            EpiLn<true> E{(const bfu*)(ws + WS_HDNB), KP.ln2_g, KP.ln2_b, KP.out + O_YP, nullptr, xch + (size_t)64 * 256 * 4, cnt_panel + 64 * 64, barw};
            pg8::gemm_phase<EpiLn<true>, pg8::StaticOrder, false, true>(lds3, g, S, E);
            sample_rows_ln(cnt_rows + 16 * 64, barw, (const float*)(ws + WS_PRE), KP.ln2_g, KP.ln2_b, KP.out + O_YP, nullptr, bid);
        }
        return;
    }
    {
        pg8::Gemm g{(const pg8::bf16_t*)(ws + WS_MIX), (const pg8::bf16_t*)(ws + WS_WOUT), MT, 1024, 2048};
        pg8::StaticOrder S; S.init(MT, 1024, G, bid);
        EpiRes E{(float*)(ws + WS_PRE), KP.x_prompt, KP.x_sample};
        pg8::gemm_phase<EpiRes, pg8::StaticOrder, true, true>(lds3, g, S, E);
    }
    xcd_barrier(xb);
    ln_phase((const float*)(ws + WS_PRE), KP.ln1_g, KP.ln1_b, (float*)(ws + WS_HDN), (bfu*)(ws + WS_HDNB), bid, G);
    xcd_barrier(xb);
    {
        pg8::Gemm g{(const pg8::bf16_t*)(ws + WS_HDNB), (const pg8::bf16_t*)(ws + WS_WGU), MT, 2 * DFF, 1024};
        pg8::StaticOrder S; S.init(MT, 2 * DFF, G, bid);
        EpiGU E{(bfu*)(ws + WS_ACT)};
        pg8::gemm_phase<EpiGU, pg8::StaticOrder, true, true>(lds3, g, S, E);
    }
    xcd_barrier(xb);
    {
        pg8::Gemm g{(const pg8::bf16_t*)(ws + WS_ACT), (const pg8::bf16_t*)(ws + WS_WDN), MT, 1024, DFF};
        pg8::StaticOrder S; S.init(MT, 1024, G, bid);
        EpiRes E{(float*)(ws + WS_PRE), (const float*)(ws + WS_HDN), (const float*)(ws + WS_HDN) + (size_t)MP * 1024};
        pg8::gemm_phase<EpiRes, pg8::StaticOrder, true, true>(lds3, g, S, E);
    }
    xcd_barrier(xb);
    ln_phase((const float*)(ws + WS_PRE), KP.ln2_g, KP.ln2_b, KP.out + O_YP, nullptr, bid, G);
}

extern "C" void kernel_launch(void* const* d_in, const int* in_sizes, int n_in, void* d_out, int out_size, void* d_ws, size_t ws_size, hipStream_t stream) {
    (void)in_sizes; (void)n_in; (void)out_size;
    static int grid_blocks = 0;
    if (!grid_blocks) {
        hipFuncSetAttribute((const void*)fwd_kernel, hipFuncAttributeMaxDynamicSharedMemorySize, LDS_BYTES);
        int dev = 0, cus = 0, per_cu = 0;
        hipGetDevice(&dev);
        hipDeviceGetAttribute(&cus, hipDeviceAttributeMultiprocessorCount, dev);
        hipOccupancyMaxActiveBlocksPerMultiprocessor(&per_cu, fwd_kernel, 512, LDS_BYTES);
        if (per_cu > 1) per_cu = 1;
        grid_blocks = cus * per_cu;
        if (grid_blocks <= 0) { fprintf(stderr, "occupancy query returned 0\n"); grid_blocks = 0; return; }
    }
    if (ws_size < WS_END) { fprintf(stderr, "workspace too small: %zu\n", ws_size); return; }
    Params p{};
    const float** pp = (const float**)&p;
    for (int i = 0; i < 22; ++i) pp[i] = (const float*)d_in[i];
    p.out = (float*)d_out; p.ws = (unsigned char*)d_ws;
    void* args[] = {&p};
    hipError_t e = hipLaunchCooperativeKernel((void*)fwd_kernel, dim3(grid_blocks), dim3(512), args, LDS_BYTES, stream);
    if (e != hipSuccess) fprintf(stderr, "cooperative launch failed: %s (grid %d)\n", hipGetErrorString(e), grid_blocks);
}
```

```cpp
#include <hip/hip_runtime.h>
#include <hip/hip_cooperative_groups.h>
#include <cstdio>
#include <cstdint>
namespace cg = cooperative_groups;
namespace pg8 {
#define PG8_LAS __attribute__((address_space(3)))
typedef unsigned short bf16_t;
typedef short bf16x8 __attribute__((ext_vector_type(8)));
typedef float f32x4 __attribute__((ext_vector_type(4)));
typedef unsigned u32x4 __attribute__((ext_vector_type(4)));
constexpr int BM = 256, BK = 64, HALF = 128, HTB = HALF * BK * 2  , STAGE_BYTES = 8 * HTB, NXCD = 8, WGM = 8;

__host__ __device__ __forceinline__ int lds_byte(int r, int c) { const int st = (r >> 4) * 2 + (c >> 5), rr = r & 15, cc = c & 31, ob = rr * 64 + cc * 2; return st * 1024 + (ob ^ (((ob >> 9) & 1) << 5)); }
__host__ __device__ __forceinline__ void stage_rc(int b, int& R, int& C) { const int st = b / 1024, sb = b % 1024, swz = sb ^ (((sb >> 9) & 1) << 5); R = (st >> 1) * 16 + swz / 64; C = (st & 1) * 32 + (swz % 64) / 2; }
__host__ __device__ __forceinline__ int perm32(int rho) { const int n = rho >> 4, i = rho & 15; return 8 * (i >> 2) + 4 * n + (i & 3); }

struct Unit { int pm, pn; };
struct Gemm { const bf16_t* A; const bf16_t* Bt; int M, N, K; };

struct StaticOrder {
    int nM, nN, nwg, G, c;
    __host__ __device__ void init(int M, int N, int G_, int c_) { nM = M / BM; nN = N / BM; nwg = nM * nN; G = G_; c = c_; }
    __host__ __device__ bool next(int i, Unit& u) const {
        const long L = (long)i * G + c; if (L >= nwg) return false;
        int wgid = (int)L; { const int q = nwg / NXCD, r = nwg % NXCD, xcd = wgid % NXCD, off = wgid / NXCD; wgid = (xcd < r ? xcd * (q + 1) : r * (q + 1) + (xcd - r) * q) + off; }
        const int nig = WGM * nN, gid = wgid / nig, fm = gid * WGM, gsz = (nM - fm) < WGM ? (nM - fm) : WGM;
        u.pm = fm + ((wgid % nig) % gsz); u.pn = (wgid % nig) / gsz; return true;
    }
    __device__ __forceinline__ void a_ready(const Unit&) const {}
    __device__ __forceinline__ void done(const Unit&) const {}
};

__device__ __forceinline__ unsigned cvt_pk_bf16(float lo, float hi) { unsigned r; asm volatile("v_cvt_pk_bf16_f32 %0, %1, %2" : "=v"(r) : "v"(lo), "v"(hi)); return r; }
template <class Epi, class Sched, bool ALIGN_EPI = false, bool SP2 = false>
__device__ __forceinline__ void gemm_phase(PG8_LAS unsigned char* lds, const Gemm g, const Sched& S, const Epi& E) {
    int tid_ = threadIdx.x; asm volatile("" : "+v"(tid_));
    const int tid = tid_, wid = __builtin_amdgcn_readfirstlane(tid >> 6), lane = tid & 63, wr = wid >> 2, wc = wid & 3, fr = lane & 15, fq = lane >> 4;
    const int K = g.K, nt = K / BK;
    unsigned voffA[2], voffB[2];
#pragma unroll
    for (int i = 0; i < 2; ++i) { int R, C; stage_rc(tid * 16 + i * 8192, R, C); const int Rb = Epi::PERM ? ((R & ~31) + perm32(R & 31)) : R;
        voffA[i] = (unsigned)(R * K + C) * 2u; voffB[i] = (unsigned)(Rb * K + C) * 2u; }
    const size_t kstep = (size_t)(BK * 2);
    const size_t hstep = (size_t)HALF * K * 2;
    const size_t tstep = 2 * hstep;
    const unsigned ldsw = (unsigned)wid * 1024u;
    const int aoff = lds_byte(wr * 64 + fr, fq * 8), boff = lds_byte(wc * 32 + fr, fq * 8);
#define PG8_SA(b, h) (((b) * 2 + (h)) * HTB)
#define PG8_SB(b, h) ((4 + (b) * 2 + (h)) * HTB)
#define PG8_STAGE(bufoff, gbase, voff) do { _Pragma("unroll") for (int _i = 0; _i < 2; ++_i) \
        __builtin_amdgcn_global_load_lds((const unsigned*)((const char*)(gbase) + (voff)[_i]), (PG8_LAS unsigned*)(lds + (bufoff) + ldsw + _i * 8192), 16, 0, 0); } while (0)
#define PG8_LDA(dst, b, h) do { _Pragma("unroll") for (int m = 0; m < 4; ++m) _Pragma("unroll") for (int k = 0; k < 2; ++k) dst[m][k] = *(const PG8_LAS bf16x8*)(lds + PG8_SA(b, h) + aoff + m * 2048 + k * 1024); } while (0)
#define PG8_LDB(dst, b, h) do { _Pragma("unroll") for (int n = 0; n < 2; ++n) _Pragma("unroll") for (int k = 0; k < 2; ++k) dst[n][k] = *(const PG8_LAS bf16x8*)(lds + PG8_SB(b, h) + boff + n * 2048 + k * 1024); } while (0)
#define PG8_MMA(ai, bj, At, Bt) do { __builtin_amdgcn_s_setprio(1); _Pragma("unroll") for (int m = 0; m < 4; ++m) _Pragma("unroll") for (int n = 0; n < 2; ++n) _Pragma("unroll") for (int k = 0; k < 2; ++k) \
        acc[ai][bj][m][n] = __builtin_amdgcn_mfma_f32_16x16x32_bf16(Bt[n][k], At[m][k], acc[ai][bj][m][n], 0, 0, 0); __builtin_amdgcn_s_setprio(0); } while (0)
#define PG8_WAIT_V(n) asm volatile("s_waitcnt vmcnt(" #n ")" ::: "memory")
#define PG8_WAIT_L(n) asm volatile("s_waitcnt lgkmcnt(" #n ")" ::: "memory")
#define PG8_BAR __builtin_amdgcn_s_barrier()
#define PG8_SCHED __builtin_amdgcn_sched_barrier(0)
    Unit cur, nxt; int ui = 0;
    if (!S.next(0, cur)) return;
    f32x4 acc[2][2][4][2];
#pragma unroll
    for (int a = 0; a < 2; ++a)
#pragma unroll
        for (int b = 0; b < 2; ++b)
#pragma unroll
            for (int m = 0; m < 4; ++m)
#pragma unroll
                for (int n = 0; n < 2; ++n) acc[a][b][m][n] = (f32x4){0.f, 0.f, 0.f, 0.f};
    bf16x8 At[4][2], B0[2][2], B1[2][2];
    const char* cA = (const char*)g.A + (size_t)cur.pm * tstep; const char* cB = (const char*)g.Bt + (size_t)cur.pn * tstep;
    S.a_ready(cur);
    if constexpr (SP2) {
        PG8_STAGE(PG8_SB(0, 0), cB, voffB); PG8_STAGE(PG8_SB(0, 1), cB + hstep, voffB); PG8_STAGE(PG8_SA(0, 0), cA, voffA); PG8_STAGE(PG8_SA(0, 1), cA + hstep, voffA);
        if (wr == 1) PG8_BAR;
        PG8_WAIT_V(2); PG8_BAR;
        PG8_STAGE(PG8_SB(1, 0), cB + kstep, voffB); PG8_STAGE(PG8_SA(1, 0), cA + kstep, voffA); PG8_STAGE(PG8_SB(1, 1), cB + hstep + kstep, voffB);
        PG8_WAIT_V(6); PG8_BAR;
    } else {
        PG8_STAGE(PG8_SB(0, 0), cB, voffB); PG8_STAGE(PG8_SA(0, 0), cA, voffA); PG8_STAGE(PG8_SB(0, 1), cB + hstep, voffB); PG8_STAGE(PG8_SA(0, 1), cA + hstep, voffA);
        if (wr == 1) PG8_BAR;
        PG8_WAIT_V(4); PG8_BAR;
        PG8_STAGE(PG8_SB(1, 0), cB + kstep, voffB); PG8_STAGE(PG8_SA(1, 0), cA + kstep, voffA); PG8_STAGE(PG8_SB(1, 1), cB + hstep + kstep, voffB);
        PG8_WAIT_V(6); PG8_BAR;
    }
    for (;;) {
        const bool has_next = S.next(ui + 1, nxt);
        const char* nA = has_next ? (const char*)g.A + (size_t)nxt.pm * tstep : cA; const char* nB = has_next ? (const char*)g.Bt + (size_t)nxt.pn * tstep : cB;
        for (int t = 0; t < nt; t += 2) {
            const bool last = (t == nt - 2);
            const char* a1 = cA + (size_t)(t + 1) * kstep;
            const char* a2 = last ? nA : cA + (size_t)(t + 2) * kstep; const char* b2 = last ? nB : cB + (size_t)(t + 2) * kstep;
            const char* a3 = a2 + kstep; const char* b3 = b2 + kstep;
            if (last && has_next) S.a_ready(nxt);
            if constexpr (SP2) {
            PG8_LDB(B0, 0, 0); PG8_LDB(B1, 0, 1); PG8_SCHED; PG8_LDA(At, 0, 0); PG8_STAGE(PG8_SA(1, 1), a1 + hstep, voffA);
            PG8_WAIT_V(8); PG8_WAIT_L(0); PG8_BAR; PG8_MMA(0, 0, At, B0); PG8_MMA(0, 1, At, B1); PG8_BAR; PG8_SCHED;
            PG8_LDA(At, 0, 1); PG8_STAGE(PG8_SB(0, 0), b2, voffB); PG8_STAGE(PG8_SB(0, 1), b2 + hstep, voffB); PG8_STAGE(PG8_SA(0, 0), a2, voffA);
            PG8_WAIT_V(8); PG8_WAIT_L(0); PG8_BAR; PG8_MMA(1, 0, At, B0); PG8_MMA(1, 1, At, B1); PG8_BAR; PG8_SCHED;
            PG8_LDB(B0, 1, 0); PG8_LDB(B1, 1, 1); PG8_SCHED; PG8_LDA(At, 1, 0); PG8_STAGE(PG8_SA(0, 1), a2 + hstep, voffA);
            PG8_WAIT_V(8); PG8_WAIT_L(0); PG8_BAR; PG8_MMA(0, 0, At, B0); PG8_MMA(0, 1, At, B1); PG8_BAR; PG8_SCHED;
            PG8_LDA(At, 1, 1); PG8_STAGE(PG8_SB(1, 0), b3, voffB); PG8_STAGE(PG8_SB(1, 1), b3 + hstep, voffB); PG8_STAGE(PG8_SA(1, 0), a3, voffA);
            PG8_WAIT_V(8); PG8_WAIT_L(0); PG8_BAR; PG8_MMA(1, 0, At, B0); PG8_MMA(1, 1, At, B1); PG8_BAR; PG8_SCHED;
            } else {
            PG8_LDB(B0, 0, 0); PG8_SCHED; PG8_LDA(At, 0, 0); PG8_STAGE(PG8_SA(1, 1), a1 + hstep, voffA);
            PG8_WAIT_L(8); PG8_BAR; PG8_WAIT_L(0); PG8_MMA(0, 0, At, B0); PG8_BAR; PG8_SCHED;
            PG8_LDB(B1, 0, 1); PG8_STAGE(PG8_SB(0, 0), b2, voffB);
            PG8_BAR; PG8_WAIT_L(0); PG8_MMA(0, 1, At, B1); PG8_BAR;
            PG8_LDA(At, 0, 1); PG8_STAGE(PG8_SA(0, 0), a2, voffA);
            PG8_BAR; PG8_WAIT_L(0); PG8_MMA(1, 0, At, B0); PG8_BAR; PG8_SCHED;
            PG8_STAGE(PG8_SB(0, 1), b2 + hstep, voffB);
            PG8_WAIT_V(6); PG8_BAR; PG8_MMA(1, 1, At, B1); PG8_BAR;
            PG8_LDB(B0, 1, 0); PG8_SCHED; PG8_LDA(At, 1, 0); PG8_STAGE(PG8_SA(0, 1), a2 + hstep, voffA);
            PG8_WAIT_L(8); PG8_BAR; PG8_WAIT_L(0); PG8_MMA(0, 0, At, B0); PG8_BAR; PG8_SCHED;
            PG8_LDB(B1, 1, 1); PG8_STAGE(PG8_SB(1, 0), b3, voffB);
            PG8_BAR; PG8_WAIT_L(0); PG8_MMA(0, 1, At, B1); PG8_BAR;
            PG8_LDA(At, 1, 1); PG8_STAGE(PG8_SA(1, 0), a3, voffA);
            PG8_BAR; PG8_WAIT_L(0); PG8_MMA(1, 0, At, B0); PG8_BAR; PG8_SCHED;
            PG8_STAGE(PG8_SB(1, 1), b3 + hstep, voffB);
            PG8_WAIT_V(6); PG8_BAR; PG8_MMA(1, 1, At, B1); PG8_BAR;
            }
        }
        if constexpr (ALIGN_EPI) { if (wr == 0) PG8_BAR; }
        if constexpr (!Epi::AFTER_DRAIN) { E(acc, cur, wr, wc, fr, fq); S.done(cur); }
        if (!has_next) break;
#pragma unroll
        for (int a = 0; a < 2; ++a)
#pragma unroll
            for (int b = 0; b < 2; ++b)
#pragma unroll
                for (int m = 0; m < 4; ++m)
#pragma unroll
                    for (int n = 0; n < 2; ++n) acc[a][b][m][n] = (f32x4){0.f, 0.f, 0.f, 0.f};
        cur = nxt; cA = nA; cB = nB; ++ui;
        if constexpr (ALIGN_EPI) { if (wr == 1) PG8_BAR; }
    }
    PG8_WAIT_V(0);
    if constexpr (!ALIGN_EPI) { if (wr == 0) PG8_BAR; }
    PG8_BAR;
    if constexpr (Epi::AFTER_DRAIN) { E.fused(acc, cur, wr, wc, fr, fq, lds, wid, lane); S.done(cur); }
#undef PG8_SA
#undef PG8_SB
#undef PG8_STAGE
#undef PG8_LDA
#undef PG8_LDB
#undef PG8_MMA
#undef PG8_WAIT_V
#undef PG8_WAIT_L
#undef PG8_BAR
#undef PG8_SCHED
}
}
#define XB_TMO      128
#define XB_XCNT(j)  (256  + 64 * (j))
#define XB_XSUB(j)  (1280 + 64 * (j))
#define XB_XGEN(j)  (2304 + 64 * (j))
#define XB_TOP      3328
#define XB_TOPGEN   3392
#define XCD_BAR_WORDS 3456
#define XB_SPIN_CAP (1u << 18)
#define LAS __attribute__((address_space(3)))

__device__ __forceinline__ unsigned xb_ld(unsigned* p)              { return __hip_atomic_load(p, __ATOMIC_RELAXED, __HIP_MEMORY_SCOPE_AGENT); }
__device__ __forceinline__ unsigned xb_add(unsigned* p, unsigned v) { return __hip_atomic_fetch_add(p, v, __ATOMIC_RELAXED, __HIP_MEMORY_SCOPE_AGENT); }
__device__ __forceinline__ unsigned xb_xcc_id() { return (unsigned)__builtin_amdgcn_s_getreg((3 << 11) | 20) & 0xFu; }
#define XB_SPIN(cond, bar) do { unsigned _sp = 0; while (cond) { __builtin_amdgcn_s_sleep(1); \
    if ((++_sp & 255u) == 0u) { if (xb_ld(&(bar)[XB_TMO])) break; if (_sp > XB_SPIN_CAP) { atomicAdd(&(bar)[XB_TMO], 1u); break; } } } } while (0)

struct XcdBarrier {
    unsigned* bar; unsigned x;
    volatile LAS unsigned* st;
};

__device__ __forceinline__ XcdBarrier xcd_barrier_post(unsigned* bar, volatile LAS unsigned* st) {
    XcdBarrier b; b.bar = bar; b.x = xb_xcc_id(); b.st = st;
    if (threadIdx.x == 0) (void)xb_add(&bar[XB_XCNT(b.x)], 1u);
    return b;
}
__device__ __forceinline__ void xcd_barrier_complete(unsigned* bar, unsigned x, unsigned& nloc, unsigned& nx) {
    const unsigned G = gridDim.x * gridDim.y * gridDim.z;
    unsigned sum, cnt, mine, sp = 0u;
    for (;;) {
        sum = 0u; cnt = 0u; mine = 0u;
#pragma unroll
        for (unsigned j = 0; j < 16; ++j) { const unsigned c = xb_ld(&bar[XB_XCNT(j)]); sum += c; cnt += (c > 0u) ? 1u : 0u; mine = (j == x) ? c : mine; }
        if (sum == G) break;
        __builtin_amdgcn_s_sleep(1);
        if ((++sp & 255u) == 0u) { if (xb_ld(&bar[XB_TMO])) break; if (sp > XB_SPIN_CAP) { atomicAdd(&bar[XB_TMO], 1u); break; } }
    }
    nloc = mine > 0u ? mine : 1u; nx = cnt > 0u ? cnt : 1u;
}

__device__ __forceinline__ void xcd_barrier(const XcdBarrier& b) {
    asm volatile("s_waitcnt vmcnt(0)" ::: "memory");
    __syncthreads();
    if (threadIdx.x == 0) {
        unsigned* bar = b.bar;
        __builtin_amdgcn_s_waitcnt(0);
        unsigned nloc = b.st[0], nx = b.st[1];
        if (nloc == 0u) { xcd_barrier_complete(bar, b.x, nloc, nx); b.st[0] = nloc; b.st[1] = nx; }
        const unsigned old = xb_add(&bar[XB_XSUB(b.x)], 1u);
        const unsigned gen = old / nloc;
        if (old + 1u == (gen + 1u) * nloc) {
            __builtin_amdgcn_fence(__ATOMIC_RELEASE, "agent");
            asm volatile("s_waitcnt vmcnt(0)" ::: "memory");
            const unsigned og = xb_add(&bar[XB_TOP], 1u);
            const unsigned tg = og / nx;
            if (og + 1u == (tg + 1u) * nx) xb_add(&bar[XB_TOPGEN], 1u);
            else XB_SPIN(xb_ld(&bar[XB_TOPGEN]) == tg, bar);
            __builtin_amdgcn_fence(__ATOMIC_ACQUIRE, "agent");
            xb_add(&bar[XB_XGEN(b.x)], 1u);
            asm volatile("s_waitcnt vmcnt(0)" ::: "memory");
        } else {
            XB_SPIN(xb_ld(&bar[XB_XGEN(b.x)]) == gen, bar);
            __builtin_amdgcn_fence(__ATOMIC_ACQUIRE, "agent");
            asm volatile("s_waitcnt vmcnt(0)" ::: "memory");
        }
    }
    __syncthreads();
}


using pg8::bf16x8; using pg8::f32x4; using pg8::Unit;
typedef unsigned short bfu;
#define LAS3 __attribute__((address_space(3)))

constexpr int MP = 16384, MT = 16640;
constexpr int NPROJ = 6144, NIN = 6160, DFF = 2816;
constexpr float ALPHA = 1.189207115002721f;
constexpr float EPS = 1e-5f;

constexpr size_t O_YP = 0, O_YS = 16777216, O_KP = 17039360, O_VP = 25427968, O_SP = 33816576, O_CP = 34340864,
                 O_KS = 34365440, O_VS = 34627584, O_SS = 34889728, O_CS = 39084032;
constexpr size_t MiB = 1u << 20;
constexpr size_t WS_WIN = 0, WS_WDT = 12 * MiB, WS_WOUT = 13 * MiB, WS_WGU = 17 * MiB, WS_WDN = 28 * MiB, WS_XB = 34 * MiB,
                 WS_PROJ = 67 * MiB, WS_VT = 262 * MiB, WS_DT = 358 * MiB, WS_XBC = 360 * MiB, WS_ATT = 425 * MiB,
                 WS_STATES = 458 * MiB, WS_HPREV = 522 * MiB, WS_DECAY = 554 * MiB, WS_YG = 555 * MiB, WS_MIX = 588 * MiB,
                 WS_PRE = 653 * MiB, WS_ATTB = 653 * MiB  , WS_LSE = 783 * MiB  , WS_HDN = 718 * MiB, WS_HDNB = 783 * MiB, WS_ACT = 816 * MiB, WS_BAR = 906 * MiB  , WS_XCH = 907 * MiB, WS_END = 909 * MiB;
constexpr int CTL_WORDS = 4096 + 2 * 64 * 64 + 2 * 16 * 64;
constexpr size_t VT_SZ = (size_t)64 * 64 * 4096;

struct Params {
    const float *x_prompt, *x_sample, *cache_k, *cache_v, *state_ssm, *state_conv, *w_in, *conv_w, *conv_b, *dt_bias, *a_log,
        *d_skip, *attn_g, *ssm_g, *w_out, *ln1_g, *ln1_b, *w_gate, *w_up, *w_down, *ln2_g, *ln2_b;
    float* out;
    unsigned char* ws;
};

typedef float f32x2_t __attribute__((ext_vector_type(2))); typedef __bf16 bf16x2_t __attribute__((ext_vector_type(2)));
__device__ __forceinline__ unsigned pk2(float lo, float hi) { f32x2_t v = {lo, hi}; bf16x2_t b = __builtin_convertvector(v, bf16x2_t); return __builtin_bit_cast(unsigned, b); }
__device__ __forceinline__ unsigned f2bf(float f) { return pk2(f, 0.f) & 0xffffu; }
__device__ __forceinline__ float bflo(unsigned u) { return __uint_as_float(u << 16); }
__device__ __forceinline__ float bfhi(unsigned u) { return __uint_as_float(u & 0xffff0000u); }
__device__ __forceinline__ float bf2f(bfu h) { return __uint_as_float((unsigned)h << 16); }
__device__ __forceinline__ float silu_f(float x) { return x * __builtin_amdgcn_rcpf(1.f + __builtin_amdgcn_exp2f(x * -1.4426950408889634f)); }
__device__ __forceinline__ float wsum(float v) { v += __shfl_xor(v, 32); v += __shfl_xor(v, 16); v += __shfl_xor(v, 8); v += __shfl_xor(v, 4); v += __shfl_xor(v, 2); v += __shfl_xor(v, 1); return v; }
__device__ __forceinline__ float wmax(float v) { v = fmaxf(v, __shfl_xor(v, 32)); v = fmaxf(v, __shfl_xor(v, 16)); v = fmaxf(v, __shfl_xor(v, 8)); v = fmaxf(v, __shfl_xor(v, 4)); v = fmaxf(v, __shfl_xor(v, 2)); v = fmaxf(v, __shfl_xor(v, 1)); return v; }
template <int CTRL> __device__ __forceinline__ float dppf(float v) { return __int_as_float(__builtin_amdgcn_update_dpp(0, __float_as_int(v), CTRL, 0xf, 0xf, false)); }
__device__ __forceinline__ float rowsum16(float v) { v += dppf<0xB1>(v); v += dppf<0x4E>(v); v += dppf<0x141>(v); v += dppf<0x140>(v); return v; }
#define MFMA16(a, b, c) __builtin_amdgcn_mfma_f32_16x16x32_bf16((a), (b), (c), 0, 0, 0)
__device__ __forceinline__ bf16x8 mk8(uint2 lo, uint2 hi) { uint4 u; u.x = lo.x; u.y = lo.y; u.z = hi.x; u.w = hi.y; return __builtin_bit_cast(bf16x8, u); }
__device__ __forceinline__ bf16x8 ld8g(const bfu* p) { return __builtin_bit_cast(bf16x8, *(const uint4*)p); }

__device__ __forceinline__ void transpose_tile(const float* __restrict__ src, int ld, int N, int K, int k0, int n0, bfu* __restrict__ dst,
                                               int blk, int stride, int off, float* tl  ) {
    const int tid = threadIdx.x;
    {
        const int n4 = (tid & 31) * 4, kk = tid >> 5;
        float4 v[4];
#pragma unroll
        for (int i = 0; i < 4; ++i) v[i] = (n0 + n4 < N) ? *(const float4*)(src + (size_t)(k0 + kk + 16 * i) * ld + n0 + n4) : make_float4(0.f, 0.f, 0.f, 0.f);
#pragma unroll
        for (int i = 0; i < 4; ++i) { float* t = tl + (kk + 16 * i) * 129 + n4; t[0] = v[i].x; t[1] = v[i].y; t[2] = v[i].z; t[3] = v[i].w; }
    }
    __syncthreads();
    {
        const int k2 = (tid & 31) * 2, nn = tid >> 5;
#pragma unroll
        for (int i = 0; i < 8; ++i) {
            const int nl = nn + 16 * i, ng = n0 + nl;
            if (ng < N) { const int row = (ng / blk) * stride + (ng % blk) + off; *(unsigned*)(dst + (size_t)row * K + k0 + k2) = pk2(tl[k2 * 129 + nl], tl[(k2 + 1) * 129 + nl]); }
        }
    }
    __syncthreads();
}

constexpr int J_IN = 16 * 48, J_DT = 16, J_OUT = 32 * 8, J_G = 16 * 22, J_U = 16 * 22, J_D = 44 * 8;
constexpr int NJ_EARLY = J_IN + J_DT, NJ_ALL = NJ_EARLY + J_OUT + J_G + J_U + J_D;
__device__ __forceinline__ void weight_job(const Params& p, int job, float* ldsf) {
    unsigned char* ws = p.ws;
    constexpr int BIG = 1 << 30;
    int j = job;
    if (j < J_IN) { transpose_tile(p.w_in, NIN, 6144, 1024, (j / 48) * 64, (j % 48) * 128, (bfu*)(ws + WS_WIN), BIG, 0, 0, ldsf); return; }
    j -= J_IN;
    if (j < J_DT) { transpose_tile(p.w_in + 6144, NIN, 16, 1024, j * 64, 0, (bfu*)(ws + WS_WDT), BIG, 0, 0, ldsf); return; }
    j -= J_DT;
    if (j < J_OUT) { transpose_tile(p.w_out, 1024, 1024, 2048, (j / 8) * 64, (j % 8) * 128, (bfu*)(ws + WS_WOUT), BIG, 0, 0, ldsf); return; }
    j -= J_OUT;
    if (j < J_G) { transpose_tile(p.w_gate, DFF, DFF, 1024, (j / 22) * 64, (j % 22) * 128, (bfu*)(ws + WS_WGU), 128, 256, 0, ldsf); return; }
    j -= J_G;
    if (j < J_U) { transpose_tile(p.w_up, DFF, DFF, 1024, (j / 22) * 64, (j % 22) * 128, (bfu*)(ws + WS_WGU), 128, 256, 128, ldsf); return; }
    j -= J_U;
    transpose_tile(p.w_down, 1024, 1024, DFF, (j / 8) * 64, (j % 8) * 128, (bfu*)(ws + WS_WDN), BIG, 0, 0, ldsf);
}

__device__ __forceinline__ void phase0(const Params& p, float* ldsf, int bid, int G) {
    unsigned char* ws = p.ws;
    const int nj = (G == 256) ? NJ_EARLY : NJ_ALL;
    for (int job = bid; job < nj; job += G) weight_job(p, job, ldsf);
    bfu* xb = (bfu*)(ws + WS_XB);
    const int NT = G * 512, gt = bid * 512 + threadIdx.x;
    {
        const float4* src = (const float4*)p.x_prompt; constexpr int N4 = MP * 256;
#pragma unroll 1
        for (int i0 = gt; i0 < N4; i0 += 8 * NT) {
            float4 v[8];
#pragma unroll
            for (int k = 0; k < 8; ++k) { const int i = i0 + k * NT; v[k] = src[i < N4 ? i : N4 - 1]; }
#pragma unroll
            for (int k = 0; k < 8; ++k) { const int i = i0 + k * NT; if (i < N4) { uint2 o; o.x = pk2(v[k].x, v[k].y); o.y = pk2(v[k].z, v[k].w); *(uint2*)(xb + (size_t)i * 4) = o; } }
        }
    }
    {
        const float4* src = (const float4*)p.x_sample; constexpr int N4 = (MT - MP) * 256;
        for (int i = gt; i < N4; i += NT) { const float4 v = src[i]; uint2 o; o.x = pk2(v.x, v.y); o.y = pk2(v.z, v.w); *(uint2*)(xb + (size_t)(MP * 256 + i) * 4) = o; }
    }
}
__device__ __forceinline__ void after_p1_filler(const Params& p, float* ldsf, int bid, int G) {
    if (G != 256 || bid < 24) return;
    for (int job = NJ_EARLY + (bid - 24); job < NJ_ALL - J_D; job += 232) weight_job(p, job, ldsf);
}
__device__ __forceinline__ void after_p9_filler(const Params& p, float* ldsf, int bid, int G) {
    if (G != 256 || bid < 150) return;
    for (int job = NJ_ALL - J_D + (bid - 150); job < NJ_ALL; job += 106) weight_job(p, job, ldsf);
}

struct EpiIn {
    static constexpr bool PERM = true, AFTER_DRAIN = false;
    bfu* proj; float* out;
    __device__ __forceinline__ void operator()(const f32x4 (&acc)[2][2][4][2], const Unit& u, int wr, int wc, int fr, int fq) const {
        const int pn = u.pn, pm = u.pm;
        const bool kv = (pn >= 4 && pn < 12), isv = pn >= 8;
        const bool sample = pm >= 64;
        const bool wr_out = kv && (sample || ((pm & 15) >= 8));
#pragma unroll
        for (int ai = 0; ai < 2; ++ai)
#pragma unroll
            for (int m = 0; m < 4; ++m) {
                const int row = pm * 256 + ai * 128 + wr * 64 + m * 16 + fr;
                float* orow = nullptr;
                if (wr_out) {
                    if (sample) orow = out + (isv ? O_VS : O_KS) + (size_t)(row - MP) * 1024;
                    else { const int b = row >> 12, t = row & 4095; orow = out + (isv ? O_VP : O_KP) + ((size_t)(b * 2048 + (t - 2048))) * 1024; }
                }
#pragma unroll
                for (int bj = 0; bj < 2; ++bj) {
                    const int col = pn * 256 + bj * 128 + wc * 32 + fq * 8;
                    const f32x4 v0 = acc[ai][bj][m][0], v1 = acc[ai][bj][m][1];
                    uint4 o; o.x = pk2(v0[0], v0[1]); o.y = pk2(v0[2], v0[3]); o.z = pk2(v1[0], v1[1]); o.w = pk2(v1[2], v1[3]);
                    *(uint4*)(proj + (size_t)row * NPROJ + col) = o;
                    if (wr_out) {
                        const int cc = col - (isv ? 2048 : 1024);
                        *(float4*)(orow + cc) = make_float4(v0[0], v0[1], v0[2], v0[3]); *(float4*)(orow + cc + 4) = make_float4(v1[0], v1[1], v1[2], v1[3]);
                    }
                }
            }
    }
};
struct EpiRes {
    static constexpr bool PERM = false, AFTER_DRAIN = false;
    float* pre; const float* res0; const float* res1;
    __device__ __forceinline__ void operator()(const f32x4 (&acc)[2][2][4][2], const Unit& u, int wr, int wc, int fr, int fq) const {
#pragma unroll
        for (int ai = 0; ai < 2; ++ai)
#pragma unroll
            for (int m = 0; m < 4; ++m) {
                const int row = u.pm * 256 + ai * 128 + wr * 64 + m * 16 + fr;
                const float* rr = (row < MP) ? res0 + (size_t)row * 1024 : res1 + (size_t)(row - MP) * 1024;
#pragma unroll
                for (int bj = 0; bj < 2; ++bj)
#pragma unroll
                    for (int n = 0; n < 2; ++n) {
                        const int col = u.pn * 256 + bj * 128 + wc * 32 + n * 16 + fq * 4;
                        const f32x4 v = acc[ai][bj][m][n];
                        const float4 x = *(const float4*)(rr + col);
                        *(float4*)(pre + (size_t)row * 1024 + col) = make_float4(v[0] + ALPHA * x.x, v[1] + ALPHA * x.y, v[2] + ALPHA * x.z, v[3] + ALPHA * x.w);
                    }
            }
    }
};
struct EpiGU {
    static constexpr bool PERM = true, AFTER_DRAIN = false;
    bfu* act;
    __device__ __forceinline__ void operator()(const f32x4 (&acc)[2][2][4][2], const Unit& u, int wr, int wc, int fr, int fq) const {
#pragma unroll
        for (int ai = 0; ai < 2; ++ai)
#pragma unroll
            for (int m = 0; m < 4; ++m) {
                const int row = u.pm * 256 + ai * 128 + wr * 64 + m * 16 + fr;
                const int col = u.pn * 128 + wc * 32 + fq * 8;
                const f32x4 g0 = acc[ai][0][m][0], g1 = acc[ai][0][m][1], u0 = acc[ai][1][m][0], u1 = acc[ai][1][m][1];
                uint4 o;
                o.x = pk2(silu_f(g0[0]) * u0[0], silu_f(g0[1]) * u0[1]); o.y = pk2(silu_f(g0[2]) * u0[2], silu_f(g0[3]) * u0[3]);
                o.z = pk2(silu_f(g1[0]) * u1[0], silu_f(g1[1]) * u1[1]); o.w = pk2(silu_f(g1[2]) * u1[2], silu_f(g1[3]) * u1[3]);
                *(uint4*)(act + (size_t)row * DFF + col) = o;
            }
    }
};

__device__ __forceinline__ void ld8f(const bfu* p, float (&r)[8]) {
    const uint4 v = *(const uint4*)p;
    r[0] = bflo(v.x); r[1] = bfhi(v.x); r[2] = bflo(v.y); r[3] = bfhi(v.y); r[4] = bflo(v.z); r[5] = bfhi(v.z); r[6] = bflo(v.w); r[7] = bfhi(v.w);
}
__device__ __forceinline__ void ld8f32(const float* p, float (&r)[8]) {
    const float4 a = *(const float4*)p, b = *(const float4*)(p + 4);
    r[0] = a.x; r[1] = a.y; r[2] = a.z; r[3] = a.w; r[4] = b.x; r[5] = b.y; r[6] = b.z; r[7] = b.w;
}
template <bool SAMPLE, int NT>
__device__ __forceinline__ void conv_run(const Params& p, int b, int row0, int t_first, int c) {
    const bfu* proj = (const bfu*)(p.ws + WS_PROJ);
    bfu* xbc = (bfu*)(p.ws + WS_XBC);
    constexpr int T = SAMPLE ? 8 : 4096;
    float w0[8], w1[8], w2[8], w3[8], cb[8];
    ld8f32(p.conv_w + c, w0); ld8f32(p.conv_w + 2048 + c, w1); ld8f32(p.conv_w + 4096 + c, w2); ld8f32(p.conv_w + 6144 + c, w3); ld8f32(p.conv_b + c, cb);
    float r0[8], r1[8], r2[8], r3[8];
    auto getraw = [&](int t, float (&r)[8]) {
        if (t >= 0) ld8f(proj + (size_t)(row0 + t) * NPROJ + 4096 + c, r);
        else if (SAMPLE) ld8f32(p.state_conv + ((size_t)b * 3 + (3 + t)) * 2048 + c, r);
        else {
#pragma unroll
            for (int j = 0; j < 8; ++j) r[j] = 0.f;
        }
    };
    getraw(t_first - 3, r0); getraw(t_first - 2, r1); getraw(t_first - 1, r2);
#pragma unroll
    for (int i = 0; i < NT; ++i) {
        const int t = t_first + i;
        getraw(t, r3);
        float o[8];
#pragma unroll
        for (int j = 0; j < 8; ++j) { const float v = cb[j] + w0[j] * r0[j] + w1[j] * r1[j] + w2[j] * r2[j] + w3[j] * r3[j]; o[j] = silu_f(v); }
        uint4 ov; ov.x = pk2(o[0], o[1]); ov.y = pk2(o[2], o[3]); ov.z = pk2(o[4], o[5]); ov.w = pk2(o[6], o[7]);
        *(uint4*)(xbc + (size_t)(row0 + t) * 2048 + c) = ov;
        if (t >= T - 3) {
            float* dst = p.out + (SAMPLE ? O_CS : O_CP) + ((size_t)b * 3 + (t - (T - 3))) * 2048 + c;
            *(float4*)dst = make_float4(r3[0], r3[1], r3[2], r3[3]); *(float4*)(dst + 4) = make_float4(r3[4], r3[5], r3[6], r3[7]);
        }
#pragma unroll
        for (int j = 0; j < 8; ++j) { r0[j] = r1[j]; r1[j] = r2[j]; r2[j] = r3[j]; }
    }
}

__device__ __forceinline__ void vt_unit(const Params& p, int unit, bfu* tile  ) {
    const int blk = unit & 15, bh = unit >> 4, h = bh & 15, b = bh >> 4, t0 = blk * 256, tid = threadIdx.x;
    const bfu* proj = (const bfu*)(p.ws + WS_PROJ);
    bfu* vt = (bfu*)(p.ws + WS_VT);
#pragma unroll
    for (int i = 0; i < 4; ++i) {
        const int e = tid + 512 * i, t = e >> 3, d8 = (e & 7) * 8;
        const uint4 v = *(const uint4*)(proj + (size_t)(b * 4096 + t0 + t) * NPROJ + 2048 + h * 64 + d8);
        bfu* tp = tile + d8 * 266 + t;
        tp[0] = (bfu)(v.x & 0xffff); tp[266] = (bfu)(v.x >> 16); tp[2 * 266] = (bfu)(v.y & 0xffff); tp[3 * 266] = (bfu)(v.y >> 16);
        tp[4 * 266] = (bfu)(v.z & 0xffff); tp[5 * 266] = (bfu)(v.z >> 16); tp[6 * 266] = (bfu)(v.w & 0xffff); tp[7 * 266] = (bfu)(v.w >> 16);
    }
    __syncthreads();
#pragma unroll
    for (int br = 0; br < 3; ++br) {
        const int dsh = 2 * br, dil = 1 << dsh, nch = (256 >> dsh) >> 3;
#pragma unroll
        for (int i = 0; i < 4; ++i) {
            const int e = tid + 512 * i, d = e >> 5, rem = e & 31, ch = rem % nch, r = rem / nch;
            const bfu* tp = tile + d * 266 + r + ((ch * 8) << dsh);
            uint4 o;
            o.x = (unsigned)tp[0] | ((unsigned)tp[dil] << 16); o.y = (unsigned)tp[2 * dil] | ((unsigned)tp[3 * dil] << 16);
            o.z = (unsigned)tp[4 * dil] | ((unsigned)tp[5 * dil] << 16); o.w = (unsigned)tp[6 * dil] | ((unsigned)tp[7 * dil] << 16);
            *(uint4*)(vt + (size_t)br * VT_SZ + ((size_t)(bh * 64 + d)) * 4096 + r * (4096 >> dsh) + (t0 >> dsh) + ch * 8) = o;
        }
    }
    __syncthreads();
}

__device__ __forceinline__ void dt_task(const Params& p, int wt) {
    const int lane = threadIdx.x & 63, l15 = lane & 15, quad = lane >> 4, r0 = wt * 16;
    const bfu* xb = (const bfu*)(p.ws + WS_XB) + (size_t)(r0 + l15) * 1024 + quad * 8;
    const bfu* wd = (const bfu*)(p.ws + WS_WDT) + (size_t)l15 * 1024 + quad * 8;
    f32x4 acc = {0.f, 0.f, 0.f, 0.f};
#pragma unroll 8
    for (int ks = 0; ks < 32; ++ks) acc = MFMA16(ld8g(xb + ks * 32), ld8g(wd + ks * 32), acc);
    float* dt = (float*)(p.ws + WS_DT);
    const float bias = p.dt_bias[l15];
#pragma unroll
    for (int j = 0; j < 4; ++j) { const float v = acc[j] + bias; dt[(size_t)(r0 + quad * 4 + j) * 16 + l15] = (v > 20.f) ? v : log1pf(__expf(v)); }
}

__device__ __forceinline__ void phase2(const Params& p, unsigned char* lds, int bid, int G) {
    constexpr int U_CP = 0, U_CS = 32, U_VT = 1024, U_DT = 130, NU = U_CP + U_CS + U_VT + U_DT;
    const int tid = threadIdx.x;
    for (int u = bid; u < NU; u += G) {
        int j = u;
        if (j < U_VT) { vt_unit(p, j, (bfu*)lds); continue; }
        j -= U_VT;
        if (j < U_CP) { const int b = j >> 7, tt = j & 127; conv_run<false, 16>(p, b, b * 4096, tt * 32 + (tid >> 8) * 16, (tid & 255) * 8); continue; }
        j -= U_CP;
        if (j < U_CS) { conv_run<true, 4>(p, j, MP + j * 8, (tid >> 8) * 4, (tid & 255) * 8); continue; }
        j -= U_CS;
        { const int wt = j * 8 + (tid >> 6); if (wt < MT / 16) dt_task(p, wt); }
    }
}

struct AttnUnit { int bh, br, r, i_start; };
__device__ __forceinline__ AttnUnit attn_decode(int bh, int br, int sub) {
    AttnUnit u; u.bh = bh; u.br = br;
    u.r = (br == 0) ? 0 : (br == 1 ? (sub & 3) : sub);
    u.i_start = ((br == 0) ? sub : (br == 1 ? (sub >> 2) : 0)) * 256;
    return u;
}
__device__ __forceinline__ void attn_stage_load(const Params& p, const AttnUnit u, uint4 (&sk)[6], uint4 (&sv)[6]) {
    const int h = u.bh & 15, b = u.bh >> 4, tid = threadIdx.x;
    const int dsh = 2 * u.br, nsub = 4096 >> dsh, k_lo = u.i_start - 128;
    const bfu* vt = (const bfu*)(p.ws + WS_VT) + (size_t)u.br * VT_SZ + (size_t)u.bh * 64 * 4096 + u.r * nsub;
    const bfu* kbase = (const bfu*)(p.ws + WS_PROJ) + (size_t)(b * 4096 + u.r) * NPROJ + 1024 + h * 64;
#pragma unroll
    for (int i = 0; i < 6; ++i) {
        const int e = tid + 512 * i;
        { const int key = e >> 3, c = e & 7; int ik = k_lo + key; ik = ik < 0 ? 0 : ik; sk[i] = *(const uint4*)(kbase + ((size_t)ik << dsh) * NPROJ + c * 8); }
        { const int d = e / 48, c = e - d * 48; int ik = k_lo + c * 8; ik = ik < 0 ? 0 : ik; sv[i] = *(const uint4*)(vt + (size_t)d * 4096 + ik); }
    }
}
__device__ __forceinline__ void attn_stage_store(const uint4 (&sk)[6], const uint4 (&sv)[6], unsigned char* ldsb) {
    bfu* Kl = (bfu*)ldsb; bfu* Vl = Kl + 384 * 72; const int tid = threadIdx.x;
#pragma unroll
    for (int i = 0; i < 6; ++i) {
        const int e = tid + 512 * i;
        { const int key = e >> 3, c = e & 7; *(uint4*)(Kl + key * 72 + c * 8) = sk[i]; }
        { const int d = e / 48, c = e - d * 48; *(uint4*)(Vl + d * 392 + c * 8) = sv[i]; }
    }
}
__device__ __forceinline__ void attn_qload(const Params& p, const AttnUnit u, bf16x8 (&qf)[4]) {
    const int h = u.bh & 15, b = u.bh >> 4, lane = threadIdx.x & 63, wave = __builtin_amdgcn_readfirstlane(threadIdx.x >> 6), l15 = lane & 15, quad = lane >> 4, dsh = 2 * u.br;
#pragma unroll
    for (int tt = 0; tt < 2; ++tt) {
        const int tq = u.r + ((u.i_start + 16 * (wave * 2 + tt) + l15) << dsh);
        const bfu* qp = (const bfu*)(p.ws + WS_PROJ) + (size_t)(b * 4096 + tq) * NPROJ + h * 64 + quad * 8;
        qf[2 * tt] = ld8g(qp); qf[2 * tt + 1] = ld8g(qp + 32);
    }
}
__device__ __forceinline__ void attn_compute(const Params& p, const AttnUnit u, unsigned char* ldsb, const bf16x8 (&qf)[4]) {
    const int bh = u.bh, br = u.br, r = u.r, i_start = u.i_start;
    const int h = bh & 15, b = bh >> 4;
    const int tid = threadIdx.x, lane = tid & 63, wave = __builtin_amdgcn_readfirstlane(tid >> 6), l15 = lane & 15, quad = lane >> 4;
    const bfu* Kl = (const bfu*)ldsb;
    const bfu* Vl = Kl + 384 * 72;
    const bfu* proj = (const bfu*)(p.ws + WS_PROJ);
    const int dsh = 2 * br;
    const float slope = exp2f(-0.5f * (float)(h + 1));
    const float NINF = -__builtin_inff();
    bfu* attb = (bfu*)(p.ws + WS_ATTB) + (size_t)br * ((size_t)MP * 1024);
    float* lse = (float*)(p.ws + WS_LSE) + (size_t)br * (MP * 16);
#pragma unroll 1
    for (int tt = 0; tt < 2; ++tt) {
        const int kb = 16 * (wave * 2 + tt);
        const int i0 = i_start + kb;
        const int tq = r + ((i0 + l15) << dsh);
        const bf16x8 q0 = tt ? qf[2] : qf[0], q1 = tt ? qf[3] : qf[1];
        f32x4 s[9];
#pragma unroll
        for (int kt = 0; kt < 9; ++kt) {
            if (kt % 3 == 0) __builtin_amdgcn_sched_barrier(0);
            const bfu* kp = Kl + (kb + 16 * kt + l15) * 72 + quad * 8;
            f32x4 a = {0.f, 0.f, 0.f, 0.f};
            a = MFMA16(*(const bf16x8*)kp, q0, a); a = MFMA16(*(const bf16x8*)(kp + 32), q1, a);
            s[kt] = a;
        }
        const int dbase = 128 + l15 - quad * 4;
        const int dmax = (i0 + l15) < 128 ? (i0 + l15) : 128;
        const float sd = slope * (float)(1 << dsh) * 1.4426950408889634f, nb = -sd * (float)dbase;
        float mx = NINF;
#pragma unroll
        for (int kt = 0; kt < 9; ++kt)
#pragma unroll
            for (int j = 0; j < 4; ++j) {
                const int cst = 16 * kt + j;
                const float bias = __builtin_fmaf(sd, (float)cst, nb);
                float v = __builtin_fmaf(s[kt][j], 0.125f * 1.4426950408889634f, bias);
                if (kt == 0 || kt == 8 || i_start == 0) v = ((unsigned)(dbase - cst) <= (unsigned)dmax) ? v : NINF;
                s[kt][j] = v; mx = fmaxf(mx, v);
            }
        mx = fmaxf(mx, __shfl_xor(mx, 16)); mx = fmaxf(mx, __shfl_xor(mx, 32));
        float den = 0.f;
#pragma unroll
        for (int kt = 0; kt < 9; ++kt)
#pragma unroll
            for (int j = 0; j < 4; ++j) { const float e = __builtin_amdgcn_exp2f(s[kt][j] - mx); s[kt][j] = e; den += e; }
        den += __shfl_xor(den, 16); den += __shfl_xor(den, 32);
        f32x4 o[4];
#pragma unroll
        for (int dt = 0; dt < 4; ++dt) o[dt] = (f32x4){0.f, 0.f, 0.f, 0.f};
#pragma unroll
        for (int kk = 0; kk < 5; ++kk) {
            uint4 pu; pu.x = pk2(s[2 * kk][0], s[2 * kk][1]); pu.y = pk2(s[2 * kk][2], s[2 * kk][3]);
            if (kk < 4) { pu.z = pk2(s[kk < 4 ? 2 * kk + 1 : 8][0], s[kk < 4 ? 2 * kk + 1 : 8][1]); pu.w = pk2(s[kk < 4 ? 2 * kk + 1 : 8][2], s[kk < 4 ? 2 * kk + 1 : 8][3]); }
            else { pu.z = 0u; pu.w = 0u; }
            const bf16x8 pf = __builtin_bit_cast(bf16x8, pu);
#pragma unroll
            for (int dt = 0; dt < 4; ++dt) {
                const bfu* vp = Vl + (dt * 16 + l15) * 392 + kb + 32 * kk + quad * 4;
                const uint2 lo = *(const uint2*)vp;
                uint2 hi; if (kk < 4) hi = *(const uint2*)(vp + 16); else { hi.x = 0u; hi.y = 0u; }
                o[dt] = MFMA16(mk8(lo, hi), pf, o[dt]);
            }
        }
        const float inv = 1.f / den;
        const size_t row = (size_t)(b * 4096 + tq);
#pragma unroll
        for (int dt = 0; dt < 4; ++dt) {
            uint2 ov; ov.x = pk2(o[dt][0] * inv, o[dt][1] * inv); ov.y = pk2(o[dt][2] * inv, o[dt][3] * inv);
            *(uint2*)(attb + row * 1024 + h * 64 + dt * 16 + quad * 4) = ov;
        }
        if (quad == 0) lse[row * 16 + h] = (mx + __log2f(den)) * 0.6931471805599453f;
    }
}

__device__ __forceinline__ void attn_sample_unit(const Params& p, int unit, float* lds) {
    const int h = unit & 15, b = unit >> 4;
    const int tid = threadIdx.x, lane = tid & 63, wave = tid >> 6, ks = lane >> 4, d4 = lane & 15;
    float* sbuf = lds + wave * 136;
    const int row = MP + b * 8 + wave;
    const bfu* proj = (const bfu*)(p.ws + WS_PROJ);
    const uint2 qu = *(const uint2*)(proj + (size_t)row * NPROJ + h * 64 + d4 * 4);
    const float q0 = bflo(qu.x) * 0.125f, q1 = bfhi(qu.x) * 0.125f, q2 = bflo(qu.y) * 0.125f, q3 = bfhi(qu.y) * 0.125f;
    const float slope = exp2f(-0.5f * (float)(h + 1));
    const float* kc = p.cache_k + ((size_t)b * 2048 * 16 + h) * 64 + d4 * 4;
    const float* vc = p.cache_v + ((size_t)b * 2048 * 16 + h) * 64 + d4 * 4;
    const float* kn = p.out + O_KS + ((size_t)b * 8 * 16 + h) * 64 + d4 * 4;
    const float* vn = p.out + O_VS + ((size_t)b * 8 * 16 + h) * 64 + d4 * 4;
    const float NINF = -__builtin_inff();
    float mr = NINF, lr = 0.f; float4 orun = make_float4(0.f, 0.f, 0.f, 0.f);
    for (int br = 0; br < 3; ++br) {
        const int dsh = 2 * br;
#pragma unroll 1
        for (int ob = 0; ob < 2; ++ob) {
            float4 kv[17];
#pragma unroll
            for (int i = 0; i < 17; ++i) {
                const int j = (ob * 17 + i) * 4 + ks, jc = j > 128 ? 128 : j;
                const int pos = 2048 + wave - (jc << dsh);
                const float* kp = (pos < 2048) ? kc + (size_t)pos * 1024 : kn + (size_t)(pos - 2048) * 1024;
                kv[i] = *(const float4*)kp;
            }
            float pr[17];
#pragma unroll
            for (int i = 0; i < 17; ++i) pr[i] = rowsum16(q0 * kv[i].x + q1 * kv[i].y + q2 * kv[i].z + q3 * kv[i].w);
#pragma unroll
            for (int i = 0; i < 17; ++i) {
                const int j = (ob * 17 + i) * 4 + ks;
                if (d4 == 0 && j <= 128) sbuf[j] = pr[i] - slope * (float)(j << dsh);
            }
        }
        __builtin_amdgcn_wave_barrier();
        const float v0 = sbuf[lane], v1 = sbuf[lane + 64], v2 = (lane == 0) ? sbuf[128] : NINF;
        const float m = wmax(fmaxf(fmaxf(v0, v1), v2));
        const float e0 = __expf(v0 - m), e1 = __expf(v1 - m), e2 = (lane == 0) ? __expf(v2 - m) : 0.f;
        const float den = wsum(e0 + e1 + e2);
        __builtin_amdgcn_wave_barrier();
        sbuf[lane] = e0; sbuf[lane + 64] = e1; if (lane == 0) sbuf[128] = e2;
        __builtin_amdgcn_wave_barrier();
        float4 acc = make_float4(0.f, 0.f, 0.f, 0.f);
#pragma unroll 1
        for (int ob = 0; ob < 2; ++ob) {
            float4 vv[17];
#pragma unroll
            for (int i = 0; i < 17; ++i) {
                const int j = (ob * 17 + i) * 4 + ks, jc = j > 128 ? 128 : j;
                const int pos = 2048 + wave - (jc << dsh);
                const float* vp = (pos < 2048) ? vc + (size_t)pos * 1024 : vn + (size_t)(pos - 2048) * 1024;
                vv[i] = *(const float4*)vp;
            }
#pragma unroll
            for (int i = 0; i < 17; ++i) {
                const int j = (ob * 17 + i) * 4 + ks, jc = j > 128 ? 128 : j;
                const float pj = (j <= 128) ? sbuf[jc] : 0.f;
                acc.x += pj * vv[i].x; acc.y += pj * vv[i].y; acc.z += pj * vv[i].z; acc.w += pj * vv[i].w;
            }
        }
        acc.x += __shfl_xor(acc.x, 16); acc.y += __shfl_xor(acc.y, 16); acc.z += __shfl_xor(acc.z, 16); acc.w += __shfl_xor(acc.w, 16);
        acc.x += __shfl_xor(acc.x, 32); acc.y += __shfl_xor(acc.y, 32); acc.z += __shfl_xor(acc.z, 32); acc.w += __shfl_xor(acc.w, 32);
        const float mn = fmaxf(mr, m), a = __expf(mr - mn), bb = __expf(m - mn);
        orun.x = orun.x * a + acc.x * bb; orun.y = orun.y * a + acc.y * bb; orun.z = orun.z * a + acc.z * bb; orun.w = orun.w * a + acc.w * bb;
        lr = lr * a + den * bb; mr = mn;
        __builtin_amdgcn_wave_barrier();
    }
    if (ks == 0) {
        const float inv = 1.f / lr;
        uint2 o; o.x = pk2(orun.x * inv, orun.y * inv); o.y = pk2(orun.z * inv, orun.w * inv);
        *(uint2*)((bfu*)(p.ws + WS_ATT) + (size_t)row * 1024 + h * 64 + d4 * 4) = o;
    }
}

__device__ __forceinline__ void ssd_cumsum(const Params& p, int row0, int g, float* csb, float* dtb) {
    const int tid = threadIdx.x, hh = tid >> 7, l = tid & 127, h = g * 4 + hh, lane = tid & 63;
    const float dt = ((const float*)(p.ws + WS_DT))[(size_t)(row0 + l) * 16 + h];
    const float a = -__expf(p.a_log[h]);
    float v = dt * a;
#pragma unroll
    for (int off = 1; off < 64; off <<= 1) { const float t = __shfl_up(v, off); if (lane >= off) v += t; }
    dtb[tid] = dt; csb[tid] = v;
    __syncthreads();
    if (l >= 64) { v += csb[hh * 128 + 63]; }
    __syncthreads();
    csb[tid] = v;
    __syncthreads();
}

__device__ __forceinline__ void conv4x8(const Params& p, int b, int c, int l0, int ch, float (&o)[4][8]) {
    const bfu* proj = (const bfu*)(p.ws + WS_PROJ);
    bfu* xbc = (bfu*)(p.ws + WS_XBC);
    float w0[8], w1[8], w2[8], w3[8], cb[8];
    ld8f32(p.conv_w + ch, w0); ld8f32(p.conv_w + 2048 + ch, w1); ld8f32(p.conv_w + 4096 + ch, w2); ld8f32(p.conv_w + 6144 + ch, w3); ld8f32(p.conv_b + ch, cb);
    const int t0 = c * 128 + l0;
    const size_t rowb = (size_t)b * 4096;
    float r[7][8];
#pragma unroll
    for (int k = 0; k < 7; ++k) {
        const int t = t0 - 3 + k;
        ld8f(proj + (rowb + (t < 0 ? 0 : t)) * NPROJ + 4096 + ch, r[k]);
        if (k < 3) {
#pragma unroll
            for (int j = 0; j < 8; ++j) r[k][j] = (t >= 0) ? r[k][j] : 0.f;
        }
    }
#pragma unroll
    for (int k = 0; k < 4; ++k) {
#pragma unroll
        for (int j = 0; j < 8; ++j) o[k][j] = silu_f(cb[j] + w0[j] * r[k][j] + w1[j] * r[k + 1][j] + w2[j] * r[k + 2][j] + w3[j] * r[k + 3][j]);
        uint4 ov; ov.x = pk2(o[k][0], o[k][1]); ov.y = pk2(o[k][2], o[k][3]); ov.z = pk2(o[k][4], o[k][5]); ov.w = pk2(o[k][6], o[k][7]);
        *(uint4*)(xbc + (rowb + t0 + k) * 2048 + ch) = ov;
        if (t0 + k >= 4093) {
            float* dst = p.out + O_CP + ((size_t)b * 3 + (t0 + k - 4093)) * 2048 + ch;
            *(float4*)dst = make_float4(r[k + 3][0], r[k + 3][1], r[k + 3][2], r[k + 3][3]); *(float4*)(dst + 4) = make_float4(r[k + 3][4], r[k + 3][5], r[k + 3][6], r[k + 3][7]);
        }
    }
}

__device__ __forceinline__ void ssd_s1_unit(const Params& p, int unit, unsigned char* ldsb) {
    const int g = unit & 3, c = (unit >> 2) & 31, b = unit >> 7;
    const int tid = threadIdx.x, lane = tid & 63, wave = __builtin_amdgcn_readfirstlane(tid >> 6), l15 = lane & 15, quad = lane >> 4;
    bfu* BT = (bfu*)ldsb;
    bfu* XT = BT + 128 * 136;
    float* csb = (float*)(XT + 256 * 136);
    float* dtb = csb + 512;
    const int row0 = b * 4096 + c * 128;
    ssd_cumsum(p, row0, g, csb, dtb);
    {
        const int hh = tid >> 7, l = tid & 127;
        const float end = csb[hh * 128 + 127], v = csb[tid], dt = dtb[tid];
        __syncthreads();
        dtb[tid] = dt * __expf(end - v);
        if (l == 127) ((float*)(p.ws + WS_DECAY))[(b * 32 + c) * 16 + g * 4 + hh] = __expf(v);
    }
    __syncthreads();
    {
        const int cgrp = tid & 15, l0 = (tid >> 4) * 4;
        float o[4][8];
        conv4x8(p, b, c, l0, 1024 + g * 128 + cgrp * 8, o);
#pragma unroll
        for (int j = 0; j < 8; ++j) { uint2 w; w.x = pk2(o[0][j], o[1][j]); w.y = pk2(o[2][j], o[3][j]); *(uint2*)(BT + (cgrp * 8 + j) * 136 + l0) = w; }
        conv4x8(p, b, c, l0, 1536 + g * 128 + cgrp * 8, o);
    }
#pragma unroll 1
    for (int i = 0; i < 2; ++i) {
        const int e = tid + 512 * i, cg32 = e & 31, l0 = (e >> 5) * 4;
        float o[4][8];
        conv4x8(p, b, c, l0, g * 256 + cg32 * 8, o);
        const float* wl = dtb + (cg32 >> 3) * 128 + l0;
        const float wa = wl[0], wb = wl[1], wc_ = wl[2], wd = wl[3];
#pragma unroll
        for (int j = 0; j < 8; ++j) { uint2 w; w.x = pk2(o[0][j] * wa, o[1][j] * wb); w.y = pk2(o[2][j] * wc_, o[3][j] * wd); *(uint2*)(XT + (cg32 * 8 + j) * 136 + l0) = w; }
    }
    __syncthreads();
    for (int hh = 0; hh < 4; ++hh) {
        const int h = g * 4 + hh;
        const bfu* XTh = XT + hh * 64 * 136;
        f32x4 acc[4];
#pragma unroll
        for (int mt = 0; mt < 4; ++mt) acc[mt] = (f32x4){0.f, 0.f, 0.f, 0.f};
#pragma unroll
        for (int ks = 0; ks < 4; ++ks) {
            const bf16x8 bfr = *(const bf16x8*)(BT + (wave * 16 + l15) * 136 + ks * 32 + quad * 8);
#pragma unroll
            for (int mt = 0; mt < 4; ++mt) { const bf16x8 afr = *(const bf16x8*)(XTh + (mt * 16 + l15) * 136 + ks * 32 + quad * 8); acc[mt] = MFMA16(bfr, afr, acc[mt]); }
        }
        bfu* st = (bfu*)(p.ws + WS_STATES) + ((size_t)((b * 32 + c) * 16 + h) * 64) * 128;
#pragma unroll
        for (int mt = 0; mt < 4; ++mt) { uint2 o; o.x = pk2(acc[mt][0], acc[mt][1]); o.y = pk2(acc[mt][2], acc[mt][3]); *(uint2*)(st + (mt * 16 + l15) * 128 + wave * 16 + quad * 4) = o; }
    }
    __syncthreads();
}

__device__ __forceinline__ void ssd_s3_unit(const Params& p, int unit, unsigned char* ldsb) {
    const int g = unit & 3, c = (unit >> 2) & 31, b = unit >> 7;
    const int tid = threadIdx.x, lane = tid & 63, wave = __builtin_amdgcn_readfirstlane(tid >> 6), l15 = lane & 15, quad = lane >> 4;
    bfu* Cs = (bfu*)ldsb;
    bfu* Bs = Cs + 128 * 136;
    bfu* XT4 = Bs + 128 * 136;
    float* csb = (float*)(XT4 + 256 * 136);
    float* dtb = csb + 512;
    const int row0 = b * 4096 + c * 128;
    const bfu* xbc = (const bfu*)(p.ws + WS_XBC);
    const bfu* proj = (const bfu*)(p.ws + WS_PROJ);
    ssd_cumsum(p, row0, g, csb, dtb);
#pragma unroll
    for (int i = 0; i < 4; ++i) {
        const int e = tid + 512 * i, l = e >> 4, n8 = (e & 15) * 8;
        *(uint4*)(Bs + l * 136 + n8) = *(const uint4*)(xbc + (size_t)(row0 + l) * 2048 + 1024 + g * 128 + n8);
        *(uint4*)(Cs + l * 136 + n8) = *(const uint4*)(xbc + (size_t)(row0 + l) * 2048 + 1536 + g * 128 + n8);
    }
#pragma unroll
    for (int i = 0; i < 8; ++i) {
        const int e = tid + 512 * i, l = e & 127, p8 = (e >> 7) * 8;
        const uint4 v = *(const uint4*)(xbc + (size_t)(row0 + l) * 2048 + g * 256 + p8);
        bfu* tp = XT4 + p8 * 136 + l;
        tp[0] = (bfu)(v.x & 0xffff); tp[136] = (bfu)(v.x >> 16); tp[2 * 136] = (bfu)(v.y & 0xffff); tp[3 * 136] = (bfu)(v.y >> 16);
        tp[4 * 136] = (bfu)(v.z & 0xffff); tp[5 * 136] = (bfu)(v.z >> 16); tp[6 * 136] = (bfu)(v.w & 0xffff); tp[7 * 136] = (bfu)(v.w >> 16);
    }
    __syncthreads();
    f32x4 cbt[8];
#pragma unroll
    for (int st = 0; st < 8; ++st) {
        f32x4 a = {0.f, 0.f, 0.f, 0.f};
        if (st <= wave) {
#pragma unroll
            for (int ks = 0; ks < 4; ++ks)
                a = MFMA16(*(const bf16x8*)(Bs + (st * 16 + l15) * 136 + ks * 32 + quad * 8), *(const bf16x8*)(Cs + (wave * 16 + l15) * 136 + ks * 32 + quad * 8), a);
        }
        cbt[st] = a;
    }
    const int lrow = wave * 16 + l15;
    for (int hh = 0; hh < 4; ++hh) {
        const int h = g * 4 + hh;
        const bfu* XT = XT4 + hh * 64 * 136;
        const float csl = csb[hh * 128 + lrow];
        f32x4 acc[4];
#pragma unroll
        for (int mt = 0; mt < 4; ++mt) acc[mt] = (f32x4){0.f, 0.f, 0.f, 0.f};
        const bfu* hp = (const bfu*)(p.ws + WS_HPREV) + ((size_t)((b * 32 + c) * 16 + h) * 64) * 128;
        bf16x8 hf[16];
#pragma unroll
        for (int i = 0; i < 16; ++i) hf[i] = ld8g(hp + (size_t)((i & 3) * 16 + l15) * 128 + (i >> 2) * 32 + quad * 8);
        __builtin_amdgcn_sched_barrier(0);
#pragma unroll
        for (int ks = 0; ks < 4; ++ks) {
            const bf16x8 bfr = *(const bf16x8*)(Cs + lrow * 136 + ks * 32 + quad * 8);
#pragma unroll
            for (int mt = 0; mt < 4; ++mt) acc[mt] = MFMA16(hf[ks * 4 + mt], bfr, acc[mt]);
        }
        const float el = __expf(csl);
#pragma unroll
        for (int mt = 0; mt < 4; ++mt) { acc[mt][0] *= el; acc[mt][1] *= el; acc[mt][2] *= el; acc[mt][3] *= el; }
#pragma unroll
        for (int kk = 0; kk < 4; ++kk) {
            if (2 * kk <= wave) {
                float mv[8];
#pragma unroll
                for (int j = 0; j < 8; ++j) {
                    const int tile = 2 * kk + (j >> 2), s = tile * 16 + quad * 4 + (j & 3);
                    const float cbv = cbt[tile][j & 3];
                    const float e = __expf(csl - csb[hh * 128 + s]) * dtb[hh * 128 + s];
                    mv[j] = (s <= lrow) ? cbv * e : 0.f;
                }
                uint4 pu; pu.x = pk2(mv[0], mv[1]); pu.y = pk2(mv[2], mv[3]); pu.z = pk2(mv[4], mv[5]); pu.w = pk2(mv[6], mv[7]);
                const bf16x8 pf = __builtin_bit_cast(bf16x8, pu);
#pragma unroll
                for (int mt = 0; mt < 4; ++mt) {
                    const bfu* xp = XT + (mt * 16 + l15) * 136 + 32 * kk + quad * 4;
                    acc[mt] = MFMA16(mk8(*(const uint2*)xp, *(const uint2*)(xp + 16)), pf, acc[mt]);
                }
            }
        }
        const float dsk = p.d_skip[h];
        const size_t row = (size_t)(row0 + lrow);
        bfu* yg = (bfu*)(p.ws + WS_YG);
#pragma unroll
        for (int mt = 0; mt < 4; ++mt) {
            const int pc = h * 64 + mt * 16 + quad * 4;
            const uint2 xu = *(const uint2*)(xbc + row * 2048 + pc);
            const uint2 zu = *(const uint2*)(proj + row * NPROJ + 3072 + pc);
            const float y0 = (acc[mt][0] + dsk * bflo(xu.x)) * silu_f(bflo(zu.x)), y1 = (acc[mt][1] + dsk * bfhi(xu.x)) * silu_f(bfhi(zu.x));
            const float y2 = (acc[mt][2] + dsk * bflo(xu.y)) * silu_f(bflo(zu.y)), y3 = (acc[mt][3] + dsk * bfhi(xu.y)) * silu_f(bfhi(zu.y));
            uint2 o; o.x = pk2(y0, y1); o.y = pk2(y2, y3);
            *(uint2*)(yg + row * 1024 + pc) = o;
        }
    }
    __syncthreads();
}

__device__ __forceinline__ void ssd_sample_unit(const Params& p, int unit, float* lds) {
    const int h = unit & 15, b = unit >> 4, g = h >> 2, tid = threadIdx.x;
    float* Bf = lds; float* Cf = Bf + 1024; float* xsf = Cf + 1024; float* cbm = xsf + 512; float* csb = cbm + 64; float* dtb = csb + 8;
    const int row0 = MP + b * 8;
    const bfu* xbc = (const bfu*)(p.ws + WS_XBC);
    const bfu* proj = (const bfu*)(p.ws + WS_PROJ);
    {
        const int l = tid >> 6, n2 = (tid & 63) * 2;
        const unsigned ub = *(const unsigned*)(xbc + (size_t)(row0 + l) * 2048 + 1024 + g * 128 + n2);
        const unsigned uc = *(const unsigned*)(xbc + (size_t)(row0 + l) * 2048 + 1536 + g * 128 + n2);
        Bf[l * 128 + n2] = bflo(ub); Bf[l * 128 + n2 + 1] = bfhi(ub); Cf[l * 128 + n2] = bflo(uc); Cf[l * 128 + n2 + 1] = bfhi(uc);
        xsf[tid] = bf2f(xbc[(size_t)(row0 + l) * 2048 + h * 64 + (tid & 63)]);
        if (tid < 8) dtb[tid] = ((const float*)(p.ws + WS_DT))[(size_t)(row0 + tid) * 16 + h];
    }
    __syncthreads();
    if (tid == 0) { const float a = -__expf(p.a_log[h]); float run = 0.f; for (int l = 0; l < 8; ++l) { run += dtb[l] * a; csb[l] = run; } }
    __syncthreads();
    if (tid < 64) {
        const int l = tid >> 3, s = tid & 7;
        float d = 0.f;
        if (s <= l) { for (int n = 0; n < 128; ++n) d += Cf[l * 128 + n] * Bf[s * 128 + n]; d *= __expf(csb[l] - csb[s]) * dtb[s]; }
        cbm[tid] = d;
    }
    __syncthreads();
    const int pp = tid >> 3, nn = tid & 7;
    const size_t soff = ((size_t)(b * 16 + h) * 64 + pp) * 128 + nn * 16;
    const float* hp = p.state_ssm + soff;
    float4 h0 = *(const float4*)hp, h1 = *(const float4*)(hp + 4), h2 = *(const float4*)(hp + 8), h3 = *(const float4*)(hp + 12);
    float myoff = 0.f;
#pragma unroll
    for (int l = 0; l < 8; ++l) {
        const float* cp = Cf + l * 128 + nn * 16;
        float part = cp[0] * h0.x + cp[1] * h0.y + cp[2] * h0.z + cp[3] * h0.w + cp[4] * h1.x + cp[5] * h1.y + cp[6] * h1.z + cp[7] * h1.w
                   + cp[8] * h2.x + cp[9] * h2.y + cp[10] * h2.z + cp[11] * h2.w + cp[12] * h3.x + cp[13] * h3.y + cp[14] * h3.z + cp[15] * h3.w;
        part += __shfl_xor(part, 1); part += __shfl_xor(part, 2); part += __shfl_xor(part, 4);
        if (nn == l) myoff = part;
    }
    const float cs7 = csb[7], e7 = __expf(cs7);
    h0.x *= e7; h0.y *= e7; h0.z *= e7; h0.w *= e7; h1.x *= e7; h1.y *= e7; h1.z *= e7; h1.w *= e7;
    h2.x *= e7; h2.y *= e7; h2.z *= e7; h2.w *= e7; h3.x *= e7; h3.y *= e7; h3.z *= e7; h3.w *= e7;
#pragma unroll
    for (int l = 0; l < 8; ++l) {
        const float w = __expf(cs7 - csb[l]) * dtb[l] * xsf[l * 64 + pp];
        const float* bp = Bf + l * 128 + nn * 16;
        h0.x += bp[0] * w; h0.y += bp[1] * w; h0.z += bp[2] * w; h0.w += bp[3] * w; h1.x += bp[4] * w; h1.y += bp[5] * w; h1.z += bp[6] * w; h1.w += bp[7] * w;
        h2.x += bp[8] * w; h2.y += bp[9] * w; h2.z += bp[10] * w; h2.w += bp[11] * w; h3.x += bp[12] * w; h3.y += bp[13] * w; h3.z += bp[14] * w; h3.w += bp[15] * w;
    }
    float* so = p.out + O_SS + soff;
    *(float4*)so = h0; *(float4*)(so + 4) = h1; *(float4*)(so + 8) = h2; *(float4*)(so + 12) = h3;
    {
        const int l = nn;
        float y = myoff * __expf(csb[l]);
#pragma unroll
        for (int s = 0; s < 8; ++s) y += cbm[l * 8 + s] * xsf[s * 64 + pp];
        y += p.d_skip[h] * xsf[l * 64 + pp];
        const float z = bf2f(proj[(size_t)(row0 + l) * NPROJ + 3072 + h * 64 + pp]);
        ((bfu*)(p.ws + WS_YG))[(size_t)(row0 + l) * 1024 + h * 64 + pp] = (bfu)f2bf(y * silu_f(z));
    }
    __syncthreads();
}

__device__ __forceinline__ void phase3(const Params& p, unsigned char* lds, int bid, int G) {
    {
        const bool xa = (G == 256);
        const int x = bid & 7, sl = bid >> 3;
        const int nun = xa ? 12 : (3072 - bid + G - 1) / G;
#define ATTN_UNIT_OF(i, U) { const int v_ = xa ? sl + 32 * (i) : bid + G * (i), rest_ = v_ % 48; U = attn_decode(xa ? x + 8 * (v_ / 48) : v_ / 48, rest_ >> 4, rest_ & 15); }
        for (int i = 0; i < nun; ++i) {
            AttnUnit uc; ATTN_UNIT_OF(i, uc);
            bf16x8 qf[4]; attn_qload(p, uc, qf);
            { uint4 sk_[6], sv_[6]; attn_stage_load(p, uc, sk_, sv_); attn_stage_store(sk_, sv_, lds); }
            __syncthreads();
            attn_compute(p, uc, lds, qf);
            __syncthreads();
        }
#undef ATTN_UNIT_OF
    }
    for (int u = bid; u < 512; u += G) attn_sample_unit(p, u, (float*)lds);
    __syncthreads();
    for (int u = bid; u < 512; u += G) ssd_s1_unit(p, u, lds);
    for (int u = bid; u < 512; u += G) ssd_sample_unit(p, u, (float*)lds);
}

__device__ __forceinline__ void phase4_scan(const Params& p, int bid, int G) {
    const bfu* states = (const bfu*)(p.ws + WS_STATES);
    const float* decay = (const float*)(p.ws + WS_DECAY);
    bfu* hprev = (bfu*)(p.ws + WS_HPREV);
    for (int i = bid * 512 + threadIdx.x; i < 131072; i += G * 512) {
        const int e = i * 4, n = e & 127, pp = (e >> 7) & 63, h = (e >> 13) & 15, b = e >> 17;
        float4 hc = make_float4(0.f, 0.f, 0.f, 0.f);
#pragma unroll 16
        for (int c = 0; c < 32; ++c) {
            const float dec = decay[(b * 32 + c) * 16 + h];
            const size_t off = ((size_t)((b * 32 + c) * 16 + h) * 64 + pp) * 128 + n;
            const uint2 su = *(const uint2*)(states + off);
            const float4 st = make_float4(bflo(su.x), bfhi(su.x), bflo(su.y), bfhi(su.y));
            uint2 o; o.x = pk2(hc.x, hc.y); o.y = pk2(hc.z, hc.w);
            *(uint2*)(hprev + off) = o;
            hc.x = hc.x * dec + st.x; hc.y = hc.y * dec + st.y; hc.z = hc.z * dec + st.z; hc.w = hc.w * dec + st.w;
        }
        *(float4*)(p.out + O_SP + ((size_t)(b * 16 + h) * 64 + pp) * 128 + n) = hc;
    }
}

__device__ __forceinline__ void rms_half(const bfu* src, const float* gam, bfu* dst, int lane) {
    float a[8], c[8];
    ld8f(src + lane * 8, a); ld8f(src + 512 + lane * 8, c);
    float ss = 0.f;
#pragma unroll
    for (int j = 0; j < 8; ++j) ss += a[j] * a[j] + c[j] * c[j];
    ss = wsum(ss);
    const float rs = rsqrtf(ss * (1.f / 1024.f) + EPS);
    float g0[8], g1[8]; ld8f32(gam + lane * 8, g0); ld8f32(gam + 512 + lane * 8, g1);
    uint4 o0, o1;
    o0.x = pk2(a[0] * rs * g0[0], a[1] * rs * g0[1]); o0.y = pk2(a[2] * rs * g0[2], a[3] * rs * g0[3]); o0.z = pk2(a[4] * rs * g0[4], a[5] * rs * g0[5]); o0.w = pk2(a[6] * rs * g0[6], a[7] * rs * g0[7]);
    o1.x = pk2(c[0] * rs * g1[0], c[1] * rs * g1[1]); o1.y = pk2(c[2] * rs * g1[2], c[3] * rs * g1[3]); o1.z = pk2(c[4] * rs * g1[4], c[5] * rs * g1[5]); o1.w = pk2(c[6] * rs * g1[6], c[7] * rs * g1[7]);
    *(uint4*)(dst + lane * 8) = o0; *(uint4*)(dst + 512 + lane * 8) = o1;
}
__device__ __forceinline__ void attn_merge_rms(const Params& p, int row, bfu* dst, int lane) {
    const bfu* attb = (const bfu*)(p.ws + WS_ATTB); const float* lse = (const float*)(p.ws + WS_LSE);
    float a[8], c[8];
#pragma unroll
    for (int j = 0; j < 8; ++j) { a[j] = 0.f; c[j] = 0.f; }
    const int h0 = lane >> 3, h1 = 8 + (lane >> 3);
    float l0[3], l1[3];
#pragma unroll
    for (int br = 0; br < 3; ++br) { l0[br] = lse[(size_t)br * (MP * 16) + (size_t)row * 16 + h0]; l1[br] = lse[(size_t)br * (MP * 16) + (size_t)row * 16 + h1]; }
    const float m0 = fmaxf(fmaxf(l0[0], l0[1]), l0[2]), m1 = fmaxf(fmaxf(l1[0], l1[1]), l1[2]);
    float w0[3], w1[3];
#pragma unroll
    for (int br = 0; br < 3; ++br) { w0[br] = __expf(l0[br] - m0); w1[br] = __expf(l1[br] - m1); }
    const float i0 = 1.f / (w0[0] + w0[1] + w0[2]), i1 = 1.f / (w1[0] + w1[1] + w1[2]);
#pragma unroll
    for (int br = 0; br < 3; ++br) {
        float x[8], y[8];
        const bfu* src = attb + (size_t)br * ((size_t)MP * 1024) + (size_t)row * 1024;
        ld8f(src + lane * 8, x); ld8f(src + 512 + lane * 8, y);
        const float f0 = w0[br] * i0, f1 = w1[br] * i1;
#pragma unroll
        for (int j = 0; j < 8; ++j) { a[j] += f0 * x[j]; c[j] += f1 * y[j]; }
    }
    float ss = 0.f;
#pragma unroll
    for (int j = 0; j < 8; ++j) ss += a[j] * a[j] + c[j] * c[j];
    ss = wsum(ss);
    const float rs = rsqrtf(ss * (1.f / 1024.f) + EPS);
    const float* gam = p.attn_g;
    float g0[8], g1[8]; ld8f32(gam + lane * 8, g0); ld8f32(gam + 512 + lane * 8, g1);
    uint4 o0, o1;
    o0.x = pk2(a[0] * rs * g0[0], a[1] * rs * g0[1]); o0.y = pk2(a[2] * rs * g0[2], a[3] * rs * g0[3]); o0.z = pk2(a[4] * rs * g0[4], a[5] * rs * g0[5]); o0.w = pk2(a[6] * rs * g0[6], a[7] * rs * g0[7]);
    o1.x = pk2(c[0] * rs * g1[0], c[1] * rs * g1[1]); o1.y = pk2(c[2] * rs * g1[2], c[3] * rs * g1[3]); o1.z = pk2(c[4] * rs * g1[4], c[5] * rs * g1[5]); o1.w = pk2(c[6] * rs * g1[6], c[7] * rs * g1[7]);
    *(uint4*)(dst + lane * 8) = o0; *(uint4*)(dst + 512 + lane * 8) = o1;
}
__device__ __forceinline__ void phase6(const Params& p, int bid, int G) {
    const int lane = threadIdx.x & 63, wave = threadIdx.x >> 6;
    const bfu* att = (const bfu*)(p.ws + WS_ATT); const bfu* yg = (const bfu*)(p.ws + WS_YG); bfu* mix = (bfu*)(p.ws + WS_MIX);
    for (int row = bid * 8 + wave; row < MT; row += G * 8) {
        if (row < MP) attn_merge_rms(p, row, mix + (size_t)row * 2048, lane);
        else rms_half(att + (size_t)row * 1024, p.attn_g, mix + (size_t)row * 2048, lane);
        rms_half(yg + (size_t)row * 1024, p.ssm_g, mix + (size_t)row * 2048 + 1024, lane);
    }
}
__device__ __forceinline__ void ln_phase(const float* pre, const float* gam, const float* bet, float* of32, bfu* obf, int bid, int G) {
    const int lane = threadIdx.x & 63, wave = threadIdx.x >> 6;
    for (int row = bid * 8 + wave; row < MT; row += G * 8) {
        const float* pr = pre + (size_t)row * 1024;
        float4 v[4];
        float s = 0.f;
#pragma unroll
        for (int i = 0; i < 4; ++i) { v[i] = *(const float4*)(pr + i * 256 + lane * 4); s += v[i].x + v[i].y + v[i].z + v[i].w; }
        const float mu = wsum(s) * (1.f / 1024.f);
        float q = 0.f;
#pragma unroll
        for (int i = 0; i < 4; ++i) { v[i].x -= mu; v[i].y -= mu; v[i].z -= mu; v[i].w -= mu; q += v[i].x * v[i].x + v[i].y * v[i].y + v[i].z * v[i].z + v[i].w * v[i].w; }
        const float rs = rsqrtf(wsum(q) * (1.f / 1024.f) + EPS);
#pragma unroll
        for (int i = 0; i < 4; ++i) {
            const int c = i * 256 + lane * 4;
            const float4 gg = *(const float4*)(gam + c), bb = *(const float4*)(bet + c);
            const float4 y = make_float4(v[i].x * rs * gg.x + bb.x, v[i].y * rs * gg.y + bb.y, v[i].z * rs * gg.z + bb.z, v[i].w * rs * gg.w + bb.w);
            if (of32) *(float4*)(of32 + (size_t)row * 1024 + c) = y;
            if (obf) { uint2 o; o.x = pk2(y.x, y.y); o.y = pk2(y.z, y.w); *(uint2*)(obf + (size_t)row * 1024 + c) = o; }
        }
    }
}


template <int K>
__device__ __forceinline__ void skinny_sample_gemm(const bfu* __restrict__ A, const bfu* __restrict__ Bt, const float* __restrict__ res, float* __restrict__ pre, float* ldsf, int bid) {
    const int tid = threadIdx.x, lane = tid & 63, wave = __builtin_amdgcn_readfirstlane(tid >> 6), l15 = lane & 15, quad = lane >> 4;
    const int rg = bid >> 4, cg = bid & 15;
    constexpr int KW = K / 8, NS = KW / 32;
    const bfu* ap = A + (size_t)(MP + rg * 16 + l15) * K + wave * KW + quad * 8;
    const bfu* bp = Bt + (size_t)(cg * 64 + l15) * K + wave * KW + quad * 8;
    f32x4 acc[4];
#pragma unroll
    for (int nt = 0; nt < 4; ++nt) acc[nt] = (f32x4){0.f, 0.f, 0.f, 0.f};
#pragma unroll
    for (int ks = 0; ks < NS; ++ks) {
        const bf16x8 af = ld8g(ap + ks * 32);
#pragma unroll
        for (int nt = 0; nt < 4; ++nt) acc[nt] = MFMA16(af, ld8g(bp + (size_t)nt * 16 * K + ks * 32), acc[nt]);
    }
#pragma unroll
    for (int nt = 0; nt < 4; ++nt)
#pragma unroll
        for (int j = 0; j < 4; ++j) ldsf[wave * 1024 + (quad * 4 + j) * 64 + nt * 16 + l15] = acc[nt][j];
    __syncthreads();
#pragma unroll
    for (int i = 0; i < 2; ++i) {
        const int e = tid + 512 * i, r = e >> 6, c = e & 63;
        float v = 0.f;
#pragma unroll
        for (int w = 0; w < 8; ++w) v += ldsf[w * 1024 + e];
        const size_t row = (size_t)(rg * 16 + r);
        pre[(MP + row) * 1024 + cg * 64 + c] = v + ALPHA * res[row * 1024 + cg * 64 + c];
    }
    __syncthreads();
}

template <bool RES_BF16>
struct EpiLn {
    static constexpr bool PERM = true, AFTER_DRAIN = true;
    const void* res; const float* gam; const float* bet; float* of32; bfu* obf;
    unsigned long long* xch;
    unsigned* cnt;
    unsigned* bar;
    __device__ __forceinline__ void operator()(const f32x4 (&)[2][2][4][2], const Unit&, int, int, int, int) const {}
    __device__ __forceinline__ void fused(f32x4 (&acc)[2][2][4][2], const Unit& u, int wr, int wc, int fr, int fq, PG8_LAS unsigned char* lds, int wid, int lane) const {
        PG8_LAS float* P = (PG8_LAS float*)lds;
        PG8_LAS float* S = (PG8_LAS float*)(lds + 8192);
        const int tid = threadIdx.x;
#pragma unroll
        for (int ai = 0; ai < 2; ++ai)
#pragma unroll
            for (int m = 0; m < 4; ++m) {
                const int rl = ai * 128 + wr * 64 + m * 16 + fr;
                const size_t roff = (size_t)(u.pm * 256 + rl) * 1024 + u.pn * 256 + wc * 32 + fq * 8;
                float s1 = 0.f, s2 = 0.f;
#pragma unroll
                for (int bj = 0; bj < 2; ++bj) {
                    float x[8];
                    if (RES_BF16) ld8f((const bfu*)res + roff + bj * 128, x);
                    else ld8f32((const float*)res + roff + bj * 128, x);
#pragma unroll
                    for (int n = 0; n < 2; ++n) {
                        f32x4 v = acc[ai][bj][m][n];
                        v[0] += ALPHA * x[4 * n]; v[1] += ALPHA * x[4 * n + 1]; v[2] += ALPHA * x[4 * n + 2]; v[3] += ALPHA * x[4 * n + 3];
                        acc[ai][bj][m][n] = v;
                        s1 += (v[0] + v[1]) + (v[2] + v[3]); s2 += (v[0] * v[0] + v[1] * v[1]) + (v[2] * v[2] + v[3] * v[3]);
                    }
                }
                s1 += __shfl_xor(s1, 16); s1 += __shfl_xor(s1, 32); s2 += __shfl_xor(s2, 16); s2 += __shfl_xor(s2, 32);
                if (fq == 0) { P[(rl * 4 + wc) * 2] = s1; P[(rl * 4 + wc) * 2 + 1] = s2; }
            }
        __syncthreads();
        if (tid < 256) {
            const float a = P[tid * 8] + P[tid * 8 + 2] + P[tid * 8 + 4] + P[tid * 8 + 6], b = P[tid * 8 + 1] + P[tid * 8 + 3] + P[tid * 8 + 5] + P[tid * 8 + 7];
            const unsigned long long pk = (unsigned long long)__float_as_uint(a) | ((unsigned long long)__float_as_uint(b) << 32);
            __hip_atomic_store(xch + ((size_t)(u.pm * 256 + tid) * 4 + u.pn), pk, __ATOMIC_RELAXED, __HIP_MEMORY_SCOPE_AGENT);
        }
        asm volatile("s_waitcnt vmcnt(0)" ::: "memory");
        __syncthreads();
        if (tid == 0) {
            __builtin_amdgcn_fence(__ATOMIC_RELEASE, "agent");
            asm volatile("s_waitcnt vmcnt(0)" ::: "memory");
            unsigned* c = cnt + u.pm * 64;
            xb_add(c, 1u);
            XB_SPIN(xb_ld(c) < 4u, bar);
            __builtin_amdgcn_fence(__ATOMIC_ACQUIRE, "agent");
            asm volatile("s_waitcnt vmcnt(0)" ::: "memory");
        }
        __syncthreads();
        if (tid < 256) {
            float a = 0.f, b = 0.f;
#pragma unroll
            for (int t = 0; t < 4; ++t) {
                const unsigned long long pk = __hip_atomic_load(xch + ((size_t)(u.pm * 256 + tid) * 4 + t), __ATOMIC_RELAXED, __HIP_MEMORY_SCOPE_AGENT);
                a += __uint_as_float((unsigned)pk); b += __uint_as_float((unsigned)(pk >> 32));
            }
            const float mu = a * (1.f / 1024.f), var = fmaxf(b * (1.f / 1024.f) - mu * mu, 0.f);
            S[tid * 2] = mu; S[tid * 2 + 1] = rsqrtf(var + EPS);
        }
        __syncthreads();
#pragma unroll
        for (int bj = 0; bj < 2; ++bj) {
            const int col = u.pn * 256 + bj * 128 + wc * 32 + fq * 8;
            float gg[8], bb[8]; ld8f32(gam + col, gg); ld8f32(bet + col, bb);
#pragma unroll
            for (int ai = 0; ai < 2; ++ai)
#pragma unroll
                for (int m = 0; m < 4; ++m) {
                    const int rl = ai * 128 + wr * 64 + m * 16 + fr;
                    const float mu = S[rl * 2], rs = S[rl * 2 + 1];
                    const f32x4 v0 = acc[ai][bj][m][0], v1 = acc[ai][bj][m][1];
                    float y[8];
#pragma unroll
                    for (int j = 0; j < 4; ++j) { y[j] = (v0[j] - mu) * rs * gg[j] + bb[j]; y[4 + j] = (v1[j] - mu) * rs * gg[4 + j] + bb[4 + j]; }
                    const size_t off = (size_t)(u.pm * 256 + rl) * 1024 + col;
                    if (of32) { *(float4*)(of32 + off) = make_float4(y[0], y[1], y[2], y[3]); *(float4*)(of32 + off + 4) = make_float4(y[4], y[5], y[6], y[7]); }
                    if (obf) { uint4 o; o.x = pk2(y[0], y[1]); o.y = pk2(y[2], y[3]); o.z = pk2(y[4], y[5]); o.w = pk2(y[6], y[7]); *(uint4*)(obf + off) = o; }
                }
        }
    }
};
__device__ __forceinline__ void sample_rows_publish(unsigned* cnt_s, int bid) {
    asm volatile("s_waitcnt vmcnt(0)" ::: "memory");
    __syncthreads();
    if (threadIdx.x == 0) { __builtin_amdgcn_fence(__ATOMIC_RELEASE, "agent"); asm volatile("s_waitcnt vmcnt(0)" ::: "memory"); xb_add(cnt_s + (bid >> 4) * 64, 1u); }
}
__device__ __forceinline__ void sample_rows_ln(unsigned* cnt_s, unsigned* bar, const float* pre, const float* gam, const float* bet, float* of32, bfu* obf, int bid) {
    if (bid >= 32) return;
    if (threadIdx.x == 0) {
        unsigned* c = cnt_s + (bid >> 1) * 64;
        XB_SPIN(xb_ld(c) < 16u, bar);
        __builtin_amdgcn_fence(__ATOMIC_ACQUIRE, "agent");
        asm volatile("s_waitcnt vmcnt(0)" ::: "memory");
    }
    __syncthreads();
    const int lane = threadIdx.x & 63, wave = threadIdx.x >> 6, row = MP + bid * 8 + wave;
    const float* pr = pre + (size_t)row * 1024;
    float4 v[4];
    float s = 0.f;
#pragma unroll
    for (int i = 0; i < 4; ++i) { v[i] = *(const float4*)(pr + i * 256 + lane * 4); s += v[i].x + v[i].y + v[i].z + v[i].w; }
    const float mu = wsum(s) * (1.f / 1024.f);
    float q = 0.f;
#pragma unroll
    for (int i = 0; i < 4; ++i) { v[i].x -= mu; v[i].y -= mu; v[i].z -= mu; v[i].w -= mu; q += v[i].x * v[i].x + v[i].y * v[i].y + v[i].z * v[i].z + v[i].w * v[i].w; }
    const float rs = rsqrtf(wsum(q) * (1.f / 1024.f) + EPS);
#pragma unroll
    for (int i = 0; i < 4; ++i) {
        const int c = i * 256 + lane * 4;
        const float4 gg = *(const float4*)(gam + c), bb = *(const float4*)(bet + c);
        const float4 y = make_float4(v[i].x * rs * gg.x + bb.x, v[i].y * rs * gg.y + bb.y, v[i].z * rs * gg.z + bb.z, v[i].w * rs * gg.w + bb.w);
        if (of32) *(float4*)(of32 + (size_t)row * 1024 + c) = y;
        if (obf) { uint2 o; o.x = pk2(y.x, y.y); o.y = pk2(y.z, y.w); *(uint2*)(obf + (size_t)row * 1024 + c) = o; }
    }
}

constexpr int LDS_BYTES = 147456;
__device__ __forceinline__ const Params& kparams() {
    unsigned long long k = (unsigned long long)__builtin_amdgcn_kernarg_segment_ptr();
    asm volatile("" : "+s"(k));
#if defined(__HIP_DEVICE_COMPILE__)
    return *(const Params*)(const __attribute__((address_space(4))) Params*)k;
#else
    return *(const Params*)k;
#endif
}
#define KP (kparams())
__global__ void __launch_bounds__(512) fwd_kernel(Params p_unused) {
    extern __shared__ __attribute__((aligned(16))) unsigned char smem[];
    cg::grid_group grid = cg::this_grid();
    const int G = gridDim.x, bid = blockIdx.x;
    unsigned char* ws = KP.ws;
    PG8_LAS unsigned char* lds3 = (PG8_LAS unsigned char*)smem;

    unsigned* barw = (unsigned*)(ws + WS_BAR);
    volatile LAS unsigned* xst = (volatile LAS unsigned*)(lds3 + (LDS_BYTES - 64));
    if (bid == 0) for (int i = threadIdx.x; i < CTL_WORDS; i += 512) barw[i] = 0u;
    if (threadIdx.x < 4) xst[threadIdx.x] = 0u;
    phase0(KP, (float*)smem, bid, G);
    grid.sync();
    const XcdBarrier xb = xcd_barrier_post(barw, xst);
    {
        pg8::Gemm g{(const pg8::bf16_t*)(ws + WS_XB), (const pg8::bf16_t*)(ws + WS_WIN), MT, NPROJ, 1024};
        pg8::StaticOrder S; S.init(MT, NPROJ, G, bid);
        EpiIn E{(bfu*)(ws + WS_PROJ), KP.out};
        pg8::gemm_phase<EpiIn, pg8::StaticOrder, false, true>(lds3, g, S, E);
        after_p1_filler(KP, (float*)smem, bid, G);
    }
    xcd_barrier(xb);
    phase2(KP, smem, bid, G);
    xcd_barrier(xb);
    phase3(KP, smem, bid, G);
    xcd_barrier(xb);
    phase4_scan(KP, bid, G);
    xcd_barrier(xb);
    for (int u = bid; u < 512; u += G) ssd_s3_unit(KP, u, smem);
    xcd_barrier(xb);
    phase6(KP, bid, G);
    xcd_barrier(xb);
    unsigned* cnt_panel = barw + 4096;
    unsigned* cnt_rows = barw + 4096 + 2 * 64 * 64;
    unsigned long long* xch = (unsigned long long*)(ws + WS_XCH);
    if (G == 256) {
        {
            skinny_sample_gemm<2048>((const bfu*)(ws + WS_MIX), (const bfu*)(ws + WS_WOUT), KP.x_sample, (float*)(ws + WS_PRE), (float*)smem, bid);
            sample_rows_publish(cnt_rows, bid);
            pg8::Gemm g{(const pg8::bf16_t*)(ws + WS_MIX), (const pg8::bf16_t*)(ws + WS_WOUT), MP, 1024, 2048};
            pg8::StaticOrder S; S.init(MP, 1024, G, bid);
            EpiLn<true> E{(const bfu*)(ws + WS_XB), KP.ln1_g, KP.ln1_b, nullptr, (bfu*)(ws + WS_HDNB), xch, cnt_panel, barw};
            pg8::gemm_phase<EpiLn<true>, pg8::StaticOrder, false, true>(lds3, g, S, E);
            sample_rows_ln(cnt_rows, barw, (const float*)(ws + WS_PRE), KP.ln1_g, KP.ln1_b, (float*)(ws + WS_HDN), (bfu*)(ws + WS_HDNB), bid);
        }
        xcd_barrier(xb);
        {
            pg8::Gemm g{(const pg8::bf16_t*)(ws + WS_HDNB), (const pg8::bf16_t*)(ws + WS_WGU), MT, 2 * DFF, 1024};
            pg8::StaticOrder S; S.init(MT, 2 * DFF, G, bid);
            EpiGU E{(bfu*)(ws + WS_ACT)};
            pg8::gemm_phase<EpiGU, pg8::StaticOrder, false, true>(lds3, g, S, E);
            after_p9_filler(KP, (float*)smem, bid, G);
        }
        xcd_barrier(xb);
        {
            skinny_sample_gemm<DFF>((const bfu*)(ws + WS_ACT), (const bfu*)(ws + WS_WDN), (const float*)(ws + WS_HDN) + (size_t)MP * 1024, (float*)(ws + WS_PRE), (float*)smem, bid);
            sample_rows_publish(cnt_rows + 16 * 64, bid);
            pg8::Gemm g{(const pg8::bf16_t*)(ws + WS_ACT), (const pg8::bf16_t*)(ws + WS_WDN), MP, 1024, DFF};
            pg8::StaticOrder S; S.init(MP, 1024, G, bid);
            EpiLn<true> E{(const bfu*)(ws + WS_HDNB), KP.ln2_g, KP.ln2_b, KP.out + O_YP, nullptr, xch + (size_t)64 * 256 * 4, cnt_panel + 64 * 64, barw};
            pg8::gemm_phase<EpiLn<true>, pg8::StaticOrder, false, true>(lds3, g, S, E);
            sample_rows_ln(cnt_rows + 16 * 64, barw, (const float*)(ws + WS_PRE), KP.ln2_g, KP.ln2_b, KP.out + O_YP, nullptr, bid);
        }
        return;
    }
    {
        pg8::Gemm g{(const pg8::bf16_t*)(ws + WS_MIX), (const pg8::bf16_t*)(ws + WS_WOUT), MT, 1024, 2048};
        pg8::StaticOrder S; S.init(MT, 1024, G, bid);
        EpiRes E{(float*)(ws + WS_PRE), KP.x_prompt, KP.x_sample};
        pg8::gemm_phase<EpiRes, pg8::StaticOrder, true, true>(lds3, g, S, E);
    }
    xcd_barrier(xb);
    ln_phase((const float*)(ws + WS_PRE), KP.ln1_g, KP.ln1_b, (float*)(ws + WS_HDN), (bfu*)(ws + WS_HDNB), bid, G);
    xcd_barrier(xb);
    {
        pg8::Gemm g{(const pg8::bf16_t*)(ws + WS_HDNB), (const pg8::bf16_t*)(ws + WS_WGU), MT, 2 * DFF, 1024};
        pg8::StaticOrder S; S.init(MT, 2 * DFF, G, bid);
        EpiGU E{(bfu*)(ws + WS_ACT)};
        pg8::gemm_phase<EpiGU, pg8::StaticOrder, true, true>(lds3, g, S, E);
    }
    xcd_barrier(xb);
    {
        pg8::Gemm g{(const pg8::bf16_t*)(ws + WS_ACT), (const pg8::bf16_t*)(ws + WS_WDN), MT, 1024, DFF};
        pg8::StaticOrder S; S.init(MT, 1024, G, bid);
        EpiRes E{(float*)(ws + WS_PRE), (const float*)(ws + WS_HDN), (const float*)(ws + WS_HDN) + (size_t)MP * 1024};
        pg8::gemm_phase<EpiRes, pg8::StaticOrder, true, true>(lds3, g, S, E);
    }
    xcd_barrier(xb);
    ln_phase((const float*)(ws + WS_PRE), KP.ln2_g, KP.ln2_b, KP.out + O_YP, nullptr, bid, G);
}

extern "C" void kernel_launch(void* const* d_in, const int* in_sizes, int n_in, void* d_out, int out_size, void* d_ws, size_t ws_size, hipStream_t stream) {
    (void)in_sizes; (void)n_in; (void)out_size;
    static int grid_blocks = 0;
    if (!grid_blocks) {
        hipFuncSetAttribute((const void*)fwd_kernel, hipFuncAttributeMaxDynamicSharedMemorySize, LDS_BYTES);
        int dev = 0, cus = 0, per_cu = 0;
        hipGetDevice(&dev);
        hipDeviceGetAttribute(&cus, hipDeviceAttributeMultiprocessorCount, dev);
        hipOccupancyMaxActiveBlocksPerMultiprocessor(&per_cu, fwd_kernel, 512, LDS_BYTES);
        if (per_cu > 1) per_cu = 1;
        grid_blocks = cus * per_cu;
        if (grid_blocks <= 0) { fprintf(stderr, "occupancy query returned 0\n"); grid_blocks = 0; return; }
    }
    if (ws_size < WS_END) { fprintf(stderr, "workspace too small: %zu\n", ws_size); return; }
    Params p{};
    const float** pp = (const float**)&p;
    for (int i = 0; i < 22; ++i) pp[i] = (const float*)d_in[i];
    p.out = (float*)d_out; p.ws = (unsigned char*)d_ws;
    void* args[] = {&p};
    hipError_t e = hipLaunchCooperativeKernel((void*)fwd_kernel, dim3(grid_blocks), dim3(512), args, LDS_BYTES, stream);
    if (e != hipSuccess) fprintf(stderr, "cooperative launch failed: %s (grid %d)\n", hipGetErrorString(e), grid_blocks);
}
```

```cpp
#include <hip/hip_runtime.h>
#include <hip/hip_cooperative_groups.h>
#include <cstdio>
#include <cstdint>
namespace cg = cooperative_groups;
namespace pg8 {
#define PG8_LAS __attribute__((address_space(3)))
typedef unsigned short bf16_t;
typedef short bf16x8 __attribute__((ext_vector_type(8)));
typedef float f32x4 __attribute__((ext_vector_type(4)));
typedef unsigned u32x4 __attribute__((ext_vector_type(4)));
constexpr int BM = 256, BK = 64, HALF = 128, HTB = HALF * BK * 2  , STAGE_BYTES = 8 * HTB, NXCD = 8, WGM = 8;

__host__ __device__ __forceinline__ int lds_byte(int r, int c) { const int st = (r >> 4) * 2 + (c >> 5), rr = r & 15, cc = c & 31, ob = rr * 64 + cc * 2; return st * 1024 + (ob ^ (((ob >> 9) & 1) << 5)); }
__host__ __device__ __forceinline__ void stage_rc(int b, int& R, int& C) { const int st = b / 1024, sb = b % 1024, swz = sb ^ (((sb >> 9) & 1) << 5); R = (st >> 1) * 16 + swz / 64; C = (st & 1) * 32 + (swz % 64) / 2; }
__host__ __device__ __forceinline__ int perm32(int rho) { const int n = rho >> 4, i = rho & 15; return 8 * (i >> 2) + 4 * n + (i & 3); }

struct Unit { int pm, pn; };
struct Gemm { const bf16_t* A; const bf16_t* Bt; int M, N, K; };

struct StaticOrder {
    int nM, nN, nwg, G, c;
    __host__ __device__ void init(int M, int N, int G_, int c_) { nM = M / BM; nN = N / BM; nwg = nM * nN; G = G_; c = c_; }
    __host__ __device__ bool next(int i, Unit& u) const {
        const long L = (long)i * G + c; if (L >= nwg) return false;
        int wgid = (int)L; { const int q = nwg / NXCD, r = nwg % NXCD, xcd = wgid % NXCD, off = wgid / NXCD; wgid = (xcd < r ? xcd * (q + 1) : r * (q + 1) + (xcd - r) * q) + off; }
        const int nig = WGM * nN, gid = wgid / nig, fm = gid * WGM, gsz = (nM - fm) < WGM ? (nM - fm) : WGM;
        u.pm = fm + ((wgid % nig) % gsz); u.pn = (wgid % nig) / gsz; return true;
    }
    __device__ __forceinline__ void a_ready(const Unit&) const {}
    __device__ __forceinline__ void done(const Unit&) const {}
};

__device__ __forceinline__ unsigned cvt_pk_bf16(float lo, float hi) { unsigned r; asm volatile("v_cvt_pk_bf16_f32 %0, %1, %2" : "=v"(r) : "v"(lo), "v"(hi)); return r; }
template <class Epi, class Sched, bool ALIGN_EPI = false, bool SP2 = false>
__device__ __forceinline__ void gemm_phase(PG8_LAS unsigned char* lds, const Gemm g, const Sched& S, const Epi& E) {
    int tid_ = threadIdx.x; asm volatile("" : "+v"(tid_));
    const int tid = tid_, wid = __builtin_amdgcn_readfirstlane(tid >> 6), lane = tid & 63, wr = wid >> 2, wc = wid & 3, fr = lane & 15, fq = lane >> 4;
    const int K = g.K, nt = K / BK;
    unsigned voffA[2], voffB[2];
#pragma unroll
    for (int i = 0; i < 2; ++i) { int R, C; stage_rc(tid * 16 + i * 8192, R, C); const int Rb = Epi::PERM ? ((R & ~31) + perm32(R & 31)) : R;
        voffA[i] = (unsigned)(R * K + C) * 2u; voffB[i] = (unsigned)(Rb * K + C) * 2u; }
    const size_t kstep = (size_t)(BK * 2);
    const size_t hstep = (size_t)HALF * K * 2;
    const size_t tstep = 2 * hstep;
    const unsigned ldsw = (unsigned)wid * 1024u;
    const int aoff = lds_byte(wr * 64 + fr, fq * 8), boff = lds_byte(wc * 32 + fr, fq * 8);
#define PG8_SA(b, h) (((b) * 2 + (h)) * HTB)
#define PG8_SB(b, h) ((4 + (b) * 2 + (h)) * HTB)
#define PG8_STAGE(bufoff, gbase, voff) do { _Pragma("unroll") for (int _i = 0; _i < 2; ++_i) \
        __builtin_amdgcn_global_load_lds((const unsigned*)((const char*)(gbase) + (voff)[_i]), (PG8_LAS unsigned*)(lds + (bufoff) + ldsw + _i * 8192), 16, 0, 0); } while (0)
#define PG8_LDA(dst, b, h) do { _Pragma("unroll") for (int m = 0; m < 4; ++m) _Pragma("unroll") for (int k = 0; k < 2; ++k) dst[m][k] = *(const PG8_LAS bf16x8*)(lds + PG8_SA(b, h) + aoff + m * 2048 + k * 1024); } while (0)
#define PG8_LDB(dst, b, h) do { _Pragma("unroll") for (int n = 0; n < 2; ++n) _Pragma("unroll") for (int k = 0; k < 2; ++k) dst[n][k] = *(const PG8_LAS bf16x8*)(lds + PG8_SB(b, h) + boff + n * 2048 + k * 1024); } while (0)
#define PG8_MMA(ai, bj, At, Bt) do { __builtin_amdgcn_s_setprio(1); _Pragma("unroll") for (int m = 0; m < 4; ++m) _Pragma("unroll") for (int n = 0; n < 2; ++n) _Pragma("unroll") for (int k = 0; k < 2; ++k) \
        acc[ai][bj][m][n] = __builtin_amdgcn_mfma_f32_16x16x32_bf16(Bt[n][k], At[m][k], acc[ai][bj][m][n], 0, 0, 0); __builtin_amdgcn_s_setprio(0); } while (0)
#define PG8_WAIT_V(n) asm volatile("s_waitcnt vmcnt(" #n ")" ::: "memory")
#define PG8_WAIT_L(n) asm volatile("s_waitcnt lgkmcnt(" #n ")" ::: "memory")
#define PG8_BAR __builtin_amdgcn_s_barrier()
#define PG8_SCHED __builtin_amdgcn_sched_barrier(0)
    Unit cur, nxt; int ui = 0;
    if (!S.next(0, cur)) return;
    f32x4 acc[2][2][4][2];
#pragma unroll
    for (int a = 0; a < 2; ++a)
#pragma unroll
        for (int b = 0; b < 2; ++b)
#pragma unroll
            for (int m = 0; m < 4; ++m)
#pragma unroll
                for (int n = 0; n < 2; ++n) acc[a][b][m][n] = (f32x4){0.f, 0.f, 0.f, 0.f};
    bf16x8 At[4][2], B0[2][2], B1[2][2];
    const char* cA = (const char*)g.A + (size_t)cur.pm * tstep; const char* cB = (const char*)g.Bt + (size_t)cur.pn * tstep;
    S.a_ready(cur);
    if constexpr (SP2) {
        PG8_STAGE(PG8_SB(0, 0), cB, voffB); PG8_STAGE(PG8_SB(0, 1), cB + hstep, voffB); PG8_STAGE(PG8_SA(0, 0), cA, voffA); PG8_STAGE(PG8_SA(0, 1), cA + hstep, voffA);
        if (wr == 1) PG8_BAR;
        PG8_WAIT_V(2); PG8_BAR;
        PG8_STAGE(PG8_SB(1, 0), cB + kstep, voffB); PG8_STAGE(PG8_SA(1, 0), cA + kstep, voffA); PG8_STAGE(PG8_SB(1, 1), cB + hstep + kstep, voffB);
        PG8_WAIT_V(6); PG8_BAR;
    } else {
        PG8_STAGE(PG8_SB(0, 0), cB, voffB); PG8_STAGE(PG8_SA(0, 0), cA, voffA); PG8_STAGE(PG8_SB(0, 1), cB + hstep, voffB); PG8_STAGE(PG8_SA(0, 1), cA + hstep, voffA);
        if (wr == 1) PG8_BAR;
        PG8_WAIT_V(4); PG8_BAR;
        PG8_STAGE(PG8_SB(1, 0), cB + kstep, voffB); PG8_STAGE(PG8_SA(1, 0), cA + kstep, voffA); PG8_STAGE(PG8_SB(1, 1), cB + hstep + kstep, voffB);
        PG8_WAIT_V(6); PG8_BAR;
    }
    for (;;) {
        const bool has_next = S.next(ui + 1, nxt);
        const char* nA = has_next ? (const char*)g.A + (size_t)nxt.pm * tstep : cA; const char* nB = has_next ? (const char*)g.Bt + (size_t)nxt.pn * tstep : cB;
        for (int t = 0; t < nt; t += 2) {
            const bool last = (t == nt - 2);
            const char* a1 = cA + (size_t)(t + 1) * kstep;
            const char* a2 = last ? nA : cA + (size_t)(t + 2) * kstep; const char* b2 = last ? nB : cB + (size_t)(t + 2) * kstep;
            const char* a3 = a2 + kstep; const char* b3 = b2 + kstep;
            if (last && has_next) S.a_ready(nxt);
            if constexpr (SP2) {
            PG8_LDB(B0, 0, 0); PG8_LDB(B1, 0, 1); PG8_SCHED; PG8_LDA(At, 0, 0); PG8_STAGE(PG8_SA(1, 1), a1 + hstep, voffA);
            PG8_WAIT_V(8); PG8_WAIT_L(0); PG8_BAR; PG8_MMA(0, 0, At, B0); PG8_MMA(0, 1, At, B1); PG8_BAR; PG8_SCHED;
            PG8_LDA(At, 0, 1); PG8_STAGE(PG8_SB(0, 0), b2, voffB); PG8_STAGE(PG8_SB(0, 1), b2 + hstep, voffB); PG8_STAGE(PG8_SA(0, 0), a2, voffA);
            PG8_WAIT_V(8); PG8_WAIT_L(0); PG8_BAR; PG8_MMA(1, 0, At, B0); PG8_MMA(1, 1, At, B1); PG8_BAR; PG8_SCHED;
            PG8_LDB(B0, 1, 0); PG8_LDB(B1, 1, 1); PG8_SCHED; PG8_LDA(At, 1, 0); PG8_STAGE(PG8_SA(0, 1), a2 + hstep, voffA);
            PG8_WAIT_V(8); PG8_WAIT_L(0); PG8_BAR; PG8_MMA(0, 0, At, B0); PG8_MMA(0, 1, At, B1); PG8_BAR; PG8_SCHED;
            PG8_LDA(At, 1, 1); PG8_STAGE(PG8_SB(1, 0), b3, voffB); PG8_STAGE(PG8_SB(1, 1), b3 + hstep, voffB); PG8_STAGE(PG8_SA(1, 0), a3, voffA);
            PG8_WAIT_V(8); PG8_WAIT_L(0); PG8_BAR; PG8_MMA(1, 0, At, B0); PG8_MMA(1, 1, At, B1); PG8_BAR; PG8_SCHED;
            } else {
            PG8_LDB(B0, 0, 0); PG8_SCHED; PG8_LDA(At, 0, 0); PG8_STAGE(PG8_SA(1, 1), a1 + hstep, voffA);
            PG8_WAIT_L(8); PG8_BAR; PG8_WAIT_L(0); PG8_MMA(0, 0, At, B0); PG8_BAR; PG8_SCHED;
            PG8_LDB(B1, 0, 1); PG8_STAGE(PG8_SB(0, 0), b2, voffB);
            PG8_BAR; PG8_WAIT_L(0); PG8_MMA(0, 1, At, B1); PG8_BAR;
            PG8_LDA(At, 0, 1); PG8_STAGE(PG8_SA(0, 0), a2, voffA);
            PG8_BAR; PG8_WAIT_L(0); PG8_MMA(1, 0, At, B0); PG8_BAR; PG8_SCHED;
            PG8_STAGE(PG8_SB(0, 1), b2 + hstep, voffB);
            PG8_WAIT_V(6); PG8_BAR; PG8_MMA(1, 1, At, B1); PG8_BAR;
            PG8_LDB(B0, 1, 0); PG8_SCHED; PG8_LDA(At, 1, 0); PG8_STAGE(PG8_SA(0, 1), a2 + hstep, voffA);
            PG8_WAIT_L(8); PG8_BAR; PG8_WAIT_L(0); PG8_MMA(0, 0, At, B0); PG8_BAR; PG8_SCHED;
            PG8_LDB(B1, 1, 1); PG8_STAGE(PG8_SB(1, 0), b3, voffB);
            PG8_BAR; PG8_WAIT_L(0); PG8_MMA(0, 1, At, B1); PG8_BAR;
            PG8_LDA(At, 1, 1); PG8_STAGE(PG8_SA(1, 0), a3, voffA);
            PG8_BAR; PG8_WAIT_L(0); PG8_MMA(1, 0, At, B0); PG8_BAR; PG8_SCHED;
            PG8_STAGE(PG8_SB(1, 1), b3 + hstep, voffB);
            PG8_WAIT_V(6); PG8_BAR; PG8_MMA(1, 1, At, B1); PG8_BAR;
            }
        }
        if constexpr (ALIGN_EPI) { if (wr == 0) PG8_BAR; }
        if constexpr (!Epi::AFTER_DRAIN) { E(acc, cur, wr, wc, fr, fq); S.done(cur); }
        if (!has_next) break;
#pragma unroll
        for (int a = 0; a < 2; ++a)
#pragma unroll
            for (int b = 0; b < 2; ++b)
#pragma unroll
                for (int m = 0; m < 4; ++m)
#pragma unroll
                    for (int n = 0; n < 2; ++n) acc[a][b][m][n] = (f32x4){0.f, 0.f, 0.f, 0.f};
        cur = nxt; cA = nA; cB = nB; ++ui;
        if constexpr (ALIGN_EPI) { if (wr == 1) PG8_BAR; }
    }
    PG8_WAIT_V(0);
    if constexpr (!ALIGN_EPI) { if (wr == 0) PG8_BAR; }
    PG8_BAR;
    if constexpr (Epi::AFTER_DRAIN) { E.fused(acc, cur, wr, wc, fr, fq, lds, wid, lane); S.done(cur); }
#undef PG8_SA
#undef PG8_SB
#undef PG8_STAGE
#undef PG8_LDA
#undef PG8_LDB
#undef PG8_MMA
#undef PG8_WAIT_V
#undef PG8_WAIT_L
#undef PG8_BAR
#undef PG8_SCHED
}
}
#define XB_TMO      128
#define XB_XCNT(j)  (256  + 64 * (j))
#define XB_XSUB(j)  (1280 + 64 * (j))
#define XB_XGEN(j)  (2304 + 64 * (j))
#define XB_TOP      3328
#define XB_TOPGEN   3392
#define XCD_BAR_WORDS 3456
#define XB_SPIN_CAP (1u << 18)
#define LAS __attribute__((address_space(3)))

__device__ __forceinline__ unsigned xb_ld(unsigned* p)              { return __hip_atomic_load(p, __ATOMIC_RELAXED, __HIP_MEMORY_SCOPE_AGENT); }
__device__ __forceinline__ unsigned xb_add(unsigned* p, unsigned v) { return __hip_atomic_fetch_add(p, v, __ATOMIC_RELAXED, __HIP_MEMORY_SCOPE_AGENT); }
__device__ __forceinline__ unsigned xb_xcc_id() { return (unsigned)__builtin_amdgcn_s_getreg((3 << 11) | 20) & 0xFu; }
#define XB_SPIN(cond, bar) do { unsigned _sp = 0; while (cond) { __builtin_amdgcn_s_sleep(1); \
    if ((++_sp & 255u) == 0u) { if (xb_ld(&(bar)[XB_TMO])) break; if (_sp > XB_SPIN_CAP) { atomicAdd(&(bar)[XB_TMO], 1u); break; } } } } while (0)

struct XcdBarrier {
    unsigned* bar; unsigned x;
    volatile LAS unsigned* st;
};

__device__ __forceinline__ XcdBarrier xcd_barrier_post(unsigned* bar, volatile LAS unsigned* st) {
    XcdBarrier b; b.bar = bar; b.x = xb_xcc_id(); b.st = st;
    if (threadIdx.x == 0) (void)xb_add(&bar[XB_XCNT(b.x)], 1u);
    return b;
}
__device__ __forceinline__ void xcd_barrier_complete(unsigned* bar, unsigned x, unsigned& nloc, unsigned& nx) {
    const unsigned G = gridDim.x * gridDim.y * gridDim.z;
    unsigned sum, cnt, mine, sp = 0u;
    for (;;) {
        sum = 0u; cnt = 0u; mine = 0u;
#pragma unroll
        for (unsigned j = 0; j < 16; ++j) { const unsigned c = xb_ld(&bar[XB_XCNT(j)]); sum += c; cnt += (c > 0u) ? 1u : 0u; mine = (j == x) ? c : mine; }
        if (sum == G) break;
        __builtin_amdgcn_s_sleep(1);
        if ((++sp & 255u) == 0u) { if (xb_ld(&bar[XB_TMO])) break; if (sp > XB_SPIN_CAP) { atomicAdd(&bar[XB_TMO], 1u); break; } }
    }
    nloc = mine > 0u ? mine : 1u; nx = cnt > 0u ? cnt : 1u;
}

__device__ __forceinline__ void xcd_barrier(const XcdBarrier& b) {
    asm volatile("s_waitcnt vmcnt(0)" ::: "memory");
    __syncthreads();
    if (threadIdx.x == 0) {
        unsigned* bar = b.bar;
        __builtin_amdgcn_s_waitcnt(0);
        unsigned nloc = b.st[0], nx = b.st[1];
        if (nloc == 0u) { xcd_barrier_complete(bar, b.x, nloc, nx); b.st[0] = nloc; b.st[1] = nx; }
        const unsigned old = xb_add(&bar[XB_XSUB(b.x)], 1u);
        const unsigned gen = old / nloc;
        if (old + 1u == (gen + 1u) * nloc) {
            __builtin_amdgcn_fence(__ATOMIC_RELEASE, "agent");
            asm volatile("s_waitcnt vmcnt(0)" ::: "memory");
            const unsigned og = xb_add(&bar[XB_TOP], 1u);
            const unsigned tg = og / nx;
            if (og + 1u == (tg + 1u) * nx) xb_add(&bar[XB_TOPGEN], 1u);
            else XB_SPIN(xb_ld(&bar[XB_TOPGEN]) == tg, bar);
            __builtin_amdgcn_fence(__ATOMIC_ACQUIRE, "agent");
            xb_add(&bar[XB_XGEN(b.x)], 1u);
            asm volatile("s_waitcnt vmcnt(0)" ::: "memory");
        } else {
            XB_SPIN(xb_ld(&bar[XB_XGEN(b.x)]) == gen, bar);
            __builtin_amdgcn_fence(__ATOMIC_ACQUIRE, "agent");
            asm volatile("s_waitcnt vmcnt(0)" ::: "memory");
        }
    }
    __syncthreads();
}


using pg8::bf16x8; using pg8::f32x4; using pg8::Unit;
typedef unsigned short bfu;
#define LAS3 __attribute__((address_space(3)))

constexpr int MP = 16384, MT = 16640;
constexpr int NPROJ = 6144, NIN = 6160, DFF = 2816;
constexpr float ALPHA = 1.189207115002721f;
constexpr float EPS = 1e-5f;

constexpr size_t O_YP = 0, O_YS = 16777216, O_KP = 17039360, O_VP = 25427968, O_SP = 33816576, O_CP = 34340864,
                 O_KS = 34365440, O_VS = 34627584, O_SS = 34889728, O_CS = 39084032;
constexpr size_t MiB = 1u << 20;
constexpr size_t WS_WIN = 0, WS_WDT = 12 * MiB, WS_WOUT = 13 * MiB, WS_WGU = 17 * MiB, WS_WDN = 28 * MiB, WS_XB = 34 * MiB,
                 WS_PROJ = 67 * MiB, WS_VT = 262 * MiB, WS_DT = 358 * MiB, WS_XBC = 360 * MiB, WS_ATT = 425 * MiB,
                 WS_STATES = 458 * MiB, WS_HPREV = 522 * MiB, WS_DECAY = 554 * MiB, WS_YG = 555 * MiB, WS_MIX = 588 * MiB,
                 WS_PRE = 653 * MiB, WS_ATTB = 653 * MiB  , WS_LSE = 783 * MiB  , WS_HDN = 718 * MiB, WS_HDNB = 783 * MiB, WS_ACT = 816 * MiB, WS_BAR = 906 * MiB  , WS_XCH = 907 * MiB, WS_END = 909 * MiB;
constexpr int CTL_WORDS = 4096 + 2 * 64 * 64 + 2 * 16 * 64;
constexpr size_t VT_SZ = (size_t)64 * 64 * 4096;

struct Params {
    const float *x_prompt, *x_sample, *cache_k, *cache_v, *state_ssm, *state_conv, *w_in, *conv_w, *conv_b, *dt_bias, *a_log,
        *d_skip, *attn_g, *ssm_g, *w_out, *ln1_g, *ln1_b, *w_gate, *w_up, *w_down, *ln2_g, *ln2_b;
    float* out;
    unsigned char* ws;
};

typedef float f32x2_t __attribute__((ext_vector_type(2))); typedef __bf16 bf16x2_t __attribute__((ext_vector_type(2)));
__device__ __forceinline__ unsigned pk2(float lo, float hi) { f32x2_t v = {lo, hi}; bf16x2_t b = __builtin_convertvector(v, bf16x2_t); return __builtin_bit_cast(unsigned, b); }
__device__ __forceinline__ unsigned f2bf(float f) { return pk2(f, 0.f) & 0xffffu; }
__device__ __forceinline__ float bflo(unsigned u) { return __uint_as_float(u << 16); }
__device__ __forceinline__ float bfhi(unsigned u) { return __uint_as_float(u & 0xffff0000u); }
__device__ __forceinline__ float bf2f(bfu h) { return __uint_as_float((unsigned)h << 16); }
__device__ __forceinline__ float silu_f(float x) { return x * __builtin_amdgcn_rcpf(1.f + __builtin_amdgcn_exp2f(x * -1.4426950408889634f)); }
__device__ __forceinline__ float wsum(float v) { v += __shfl_xor(v, 32); v += __shfl_xor(v, 16); v += __shfl_xor(v, 8); v += __shfl_xor(v, 4); v += __shfl_xor(v, 2); v += __shfl_xor(v, 1); return v; }
__device__ __forceinline__ float wmax(float v) { v = fmaxf(v, __shfl_xor(v, 32)); v = fmaxf(v, __shfl_xor(v, 16)); v = fmaxf(v, __shfl_xor(v, 8)); v = fmaxf(v, __shfl_xor(v, 4)); v = fmaxf(v, __shfl_xor(v, 2)); v = fmaxf(v, __shfl_xor(v, 1)); return v; }
template <int CTRL> __device__ __forceinline__ float dppf(float v) { return __int_as_float(__builtin_amdgcn_update_dpp(0, __float_as_int(v), CTRL, 0xf, 0xf, false)); }
__device__ __forceinline__ float rowsum16(float v) { v += dppf<0xB1>(v); v += dppf<0x4E>(v); v += dppf<0x141>(v); v += dppf<0x140>(v); return v; }
#define MFMA16(a, b, c) __builtin_amdgcn_mfma_f32_16x16x32_bf16((a), (b), (c), 0, 0, 0)
__device__ __forceinline__ bf16x8 mk8(uint2 lo, uint2 hi) { uint4 u; u.x = lo.x; u.y = lo.y; u.z = hi.x; u.w = hi.y; return __builtin_bit_cast(bf16x8, u); }
__device__ __forceinline__ bf16x8 ld8g(const bfu* p) { return __builtin_bit_cast(bf16x8, *(const uint4*)p); }

__device__ __forceinline__ void transpose_tile(const float* __restrict__ src, int ld, int N, int K, int k0, int n0, bfu* __restrict__ dst,
                                               int blk, int stride, int off, float* tl  ) {
    const int tid = threadIdx.x;
    {
        const int n4 = (tid & 31) * 4, kk = tid >> 5;
        float4 v[4];
#pragma unroll
        for (int i = 0; i < 4; ++i) v[i] = (n0 + n4 < N) ? *(const float4*)(src + (size_t)(k0 + kk + 16 * i) * ld + n0 + n4) : make_float4(0.f, 0.f, 0.f, 0.f);
#pragma unroll
        for (int i = 0; i < 4; ++i) { float* t = tl + (kk + 16 * i) * 129 + n4; t[0] = v[i].x; t[1] = v[i].y; t[2] = v[i].z; t[3] = v[i].w; }
    }
    __syncthreads();
    {
        const int k2 = (tid & 31) * 2, nn = tid >> 5;
#pragma unroll
        for (int i = 0; i < 8; ++i) {
            const int nl = nn + 16 * i, ng = n0 + nl;
            if (ng < N) { const int row = (ng / blk) * stride + (ng % blk) + off; *(unsigned*)(dst + (size_t)row * K + k0 + k2) = pk2(tl[k2 * 129 + nl], tl[(k2 + 1) * 129 + nl]); }
        }
    }
    __syncthreads();
}

constexpr int J_IN = 16 * 48, J_DT = 16, J_OUT = 32 * 8, J_G = 16 * 22, J_U = 16 * 22, J_D = 44 * 8;
constexpr int NJ_EARLY = J_IN + J_DT, NJ_ALL = NJ_EARLY + J_OUT + J_G + J_U + J_D;
__device__ __forceinline__ void weight_job(const Params& p, int job, float* ldsf) {
    unsigned char* ws = p.ws;
    constexpr int BIG = 1 << 30;
    int j = job;
    if (j < J_IN) { transpose_tile(p.w_in, NIN, 6144, 1024, (j / 48) * 64, (j % 48) * 128, (bfu*)(ws + WS_WIN), BIG, 0, 0, ldsf); return; }
    j -= J_IN;
    if (j < J_DT) { transpose_tile(p.w_in + 6144, NIN, 16, 1024, j * 64, 0, (bfu*)(ws + WS_WDT), BIG, 0, 0, ldsf); return; }
    j -= J_DT;
    if (j < J_OUT) { transpose_tile(p.w_out, 1024, 1024, 2048, (j / 8) * 64, (j % 8) * 128, (bfu*)(ws + WS_WOUT), BIG, 0, 0, ldsf); return; }
    j -= J_OUT;
    if (j < J_G) { transpose_tile(p.w_gate, DFF, DFF, 1024, (j / 22) * 64, (j % 22) * 128, (bfu*)(ws + WS_WGU), 128, 256, 0, ldsf); return; }
    j -= J_G;
    if (j < J_U) { transpose_tile(p.w_up, DFF, DFF, 1024, (j / 22) * 64, (j % 22) * 128, (bfu*)(ws + WS_WGU), 128, 256, 128, ldsf); return; }
    j -= J_U;
    transpose_tile(p.w_down, 1024, 1024, DFF, (j / 8) * 64, (j % 8) * 128, (bfu*)(ws + WS_WDN), BIG, 0, 0, ldsf);
}

__device__ __forceinline__ void phase0(const Params& p, float* ldsf, int bid, int G) {
    unsigned char* ws = p.ws;
    const int nj = (G == 256) ? NJ_EARLY : NJ_ALL;
    for (int job = bid; job < nj; job += G) weight_job(p, job, ldsf);
    bfu* xb = (bfu*)(ws + WS_XB);
    const int NT = G * 512, gt = bid * 512 + threadIdx.x;
    {
        const float4* src = (const float4*)p.x_prompt; constexpr int N4 = MP * 256;
#pragma unroll 1
        for (int i0 = gt; i0 < N4; i0 += 8 * NT) {
            float4 v[8];
#pragma unroll
            for (int k = 0; k < 8; ++k) { const int i = i0 + k * NT; v[k] = src[i < N4 ? i : N4 - 1]; }
#pragma unroll
            for (int k = 0; k < 8; ++k) { const int i = i0 + k * NT; if (i < N4) { uint2 o; o.x = pk2(v[k].x, v[k].y); o.y = pk2(v[k].z, v[k].w); *(uint2*)(xb + (size_t)i * 4) = o; } }
        }
    }
    {
        const float4* src = (const float4*)p.x_sample; constexpr int N4 = (MT - MP) * 256;
        for (int i = gt; i < N4; i += NT) { const float4 v = src[i]; uint2 o; o.x = pk2(v.x, v.y); o.y = pk2(v.z, v.w); *(uint2*)(xb + (size_t)(MP * 256 + i) * 4) = o; }
    }
}
__device__ __forceinline__ void after_p1_filler(const Params& p, float* ldsf, int bid, int G) {
    if (G != 256 || bid < 24) return;
    for (int job = NJ_EARLY + (bid - 24); job < NJ_ALL - J_D; job += 232) weight_job(p, job, ldsf);
}
__device__ __forceinline__ void after_p9_filler(const Params& p, float* ldsf, int bid, int G) {
    if (G != 256 || bid < 150) return;
    for (int job = NJ_ALL - J_D + (bid - 150); job < NJ_ALL; job += 106) weight_job(p, job, ldsf);
}

struct EpiIn {
    static constexpr bool PERM = true, AFTER_DRAIN = false;
    bfu* proj; float* out;
    __device__ __forceinline__ void operator()(const f32x4 (&acc)[2][2][4][2], const Unit& u, int wr, int wc, int fr, int fq) const {
        const int pn = u.pn, pm = u.pm;
        const bool kv = (pn >= 4 && pn < 12), isv = pn >= 8;
        const bool sample = pm >= 64;
        const bool wr_out = kv && (sample || ((pm & 15) >= 8));
#pragma unroll
        for (int ai = 0; ai < 2; ++ai)
#pragma unroll
            for (int m = 0; m < 4; ++m) {
                const int row = pm * 256 + ai * 128 + wr * 64 + m * 16 + fr;
                float* orow = nullptr;
                if (wr_out) {
                    if (sample) orow = out + (isv ? O_VS : O_KS) + (size_t)(row - MP) * 1024;
                    else { const int b = row >> 12, t = row & 4095; orow = out + (isv ? O_VP : O_KP) + ((size_t)(b * 2048 + (t - 2048))) * 1024; }
                }
#pragma unroll
                for (int bj = 0; bj < 2; ++bj) {
                    const int col = pn * 256 + bj * 128 + wc * 32 + fq * 8;
                    const f32x4 v0 = acc[ai][bj][m][0], v1 = acc[ai][bj][m][1];
                    uint4 o; o.x = pk2(v0[0], v0[1]); o.y = pk2(v0[2], v0[3]); o.z = pk2(v1[0], v1[1]); o.w = pk2(v1[2], v1[3]);
                    *(uint4*)(proj + (size_t)row * NPROJ + col) = o;
                    if (wr_out) {
                        const int cc = col - (isv ? 2048 : 1024);
                        *(float4*)(orow + cc) = make_float4(v0[0], v0[1], v0[2], v0[3]); *(float4*)(orow + cc + 4) = make_float4(v1[0], v1[1], v1[2], v1[3]);
                    }
                }
            }
    }
};
struct EpiRes {
    static constexpr bool PERM = false, AFTER_DRAIN = false;
    float* pre; const float* res0; const float* res1;
    __device__ __forceinline__ void operator()(const f32x4 (&acc)[2][2][4][2], const Unit& u, int wr, int wc, int fr, int fq) const {
#pragma unroll
        for (int ai = 0; ai < 2; ++ai)
#pragma unroll
            for (int m = 0; m < 4; ++m) {
                const int row = u.pm * 256 + ai * 128 + wr * 64 + m * 16 + fr;
                const float* rr = (row < MP) ? res0 + (size_t)row * 1024 : res1 + (size_t)(row - MP) * 1024;
#pragma unroll
                for (int bj = 0; bj < 2; ++bj)
#pragma unroll
                    for (int n = 0; n < 2; ++n) {
                        const int col = u.pn * 256 + bj * 128 + wc * 32 + n * 16 + fq * 4;
                        const f32x4 v = acc[ai][bj][m][n];
                        const float4 x = *(const float4*)(rr + col);
                        *(float4*)(pre + (size_t)row * 1024 + col) = make_float4(v[0] + ALPHA * x.x, v[1] + ALPHA * x.y, v[2] + ALPHA * x.z, v[3] + ALPHA * x.w);
                    }
            }
    }
};
struct EpiGU {
    static constexpr bool PERM = true, AFTER_DRAIN = false;
    bfu* act;
    __device__ __forceinline__ void operator()(const f32x4 (&acc)[2][2][4][2], const Unit& u, int wr, int wc, int fr, int fq) const {
#pragma unroll
        for (int ai = 0; ai < 2; ++ai)
#pragma unroll
            for (int m = 0; m < 4; ++m) {
                const int row = u.pm * 256 + ai * 128 + wr * 64 + m * 16 + fr;
                const int col = u.pn * 128 + wc * 32 + fq * 8;
                const f32x4 g0 = acc[ai][0][m][0], g1 = acc[ai][0][m][1], u0 = acc[ai][1][m][0], u1 = acc[ai][1][m][1];
                uint4 o;
                o.x = pk2(silu_f(g0[0]) * u0[0], silu_f(g0[1]) * u0[1]); o.y = pk2(silu_f(g0[2]) * u0[2], silu_f(g0[3]) * u0[3]);
                o.z = pk2(silu_f(g1[0]) * u1[0], silu_f(g1[1]) * u1[1]); o.w = pk2(silu_f(g1[2]) * u1[2], silu_f(g1[3]) * u1[3]);
                *(uint4*)(act + (size_t)row * DFF + col) = o;
            }
    }
};

__device__ __forceinline__ void ld8f(const bfu* p, float (&r)[8]) {
    const uint4 v = *(const uint4*)p;
    r[0] = bflo(v.x); r[1] = bfhi(v.x); r[2] = bflo(v.y); r[3] = bfhi(v.y); r[4] = bflo(v.z); r[5] = bfhi(v.z); r[6] = bflo(v.w); r[7] = bfhi(v.w);
}
__device__ __forceinline__ void ld8f32(const float* p, float (&r)[8]) {
    const float4 a = *(const float4*)p, b = *(const float4*)(p + 4);
    r[0] = a.x; r[1] = a.y; r[2] = a.z; r[3] = a.w; r[4] = b.x; r[5] = b.y; r[6] = b.z; r[7] = b.w;
}
template <bool SAMPLE, int NT>
__device__ __forceinline__ void conv_run(const Params& p, int b, int row0, int t_first, int c) {
    const bfu* proj = (const bfu*)(p.ws + WS_PROJ);
    bfu* xbc = (bfu*)(p.ws + WS_XBC);
    constexpr int T = SAMPLE ? 8 : 4096;
    float w0[8], w1[8], w2[8], w3[8], cb[8];
    ld8f32(p.conv_w + c, w0); ld8f32(p.conv_w + 2048 + c, w1); ld8f32(p.conv_w + 4096 + c, w2); ld8f32(p.conv_w + 6144 + c, w3); ld8f32(p.conv_b + c, cb);
    float r0[8], r1[8], r2[8], r3[8];
    auto getraw = [&](int t, float (&r)[8]) {
        if (t >= 0) ld8f(proj + (size_t)(row0 + t) * NPROJ + 4096 + c, r);
        else if (SAMPLE) ld8f32(p.state_conv + ((size_t)b * 3 + (3 + t)) * 2048 + c, r);
        else {
#pragma unroll
            for (int j = 0; j < 8; ++j) r[j] = 0.f;
        }
    };
    getraw(t_first - 3, r0); getraw(t_first - 2, r1); getraw(t_first - 1, r2);
#pragma unroll
    for (int i = 0; i < NT; ++i) {
        const int t = t_first + i;
        getraw(t, r3);
        float o[8];
#pragma unroll
        for (int j = 0; j < 8; ++j) { const float v = cb[j] + w0[j] * r0[j] + w1[j] * r1[j] + w2[j] * r2[j] + w3[j] * r3[j]; o[j] = silu_f(v); }
        uint4 ov; ov.x = pk2(o[0], o[1]); ov.y = pk2(o[2], o[3]); ov.z = pk2(o[4], o[5]); ov.w = pk2(o[6], o[7]);
        *(uint4*)(xbc + (size_t)(row0 + t) * 2048 + c) = ov;
        if (t >= T - 3) {
            float* dst = p.out + (SAMPLE ? O_CS : O_CP) + ((size_t)b * 3 + (t - (T - 3))) * 2048 + c;
            *(float4*)dst = make_float4(r3[0], r3[1], r3[2], r3[3]); *(float4*)(dst + 4) = make_float4(r3[4], r3[5], r3[6], r3[7]);
        }
#pragma unroll
        for (int j = 0; j < 8; ++j) { r0[j] = r1[j]; r1[j] = r2[j]; r2[j] = r3[j]; }
    }
}

__device__ __forceinline__ void vt_unit(const Params& p, int unit, bfu* tile  ) {
    const int blk = unit & 15, bh = unit >> 4, h = bh & 15, b = bh >> 4, t0 = blk * 256, tid = threadIdx.x;
    const bfu* proj = (const bfu*)(p.ws + WS_PROJ);
    bfu* vt = (bfu*)(p.ws + WS_VT);
#pragma unroll
    for (int i = 0; i < 4; ++i) {
        const int e = tid + 512 * i, t = e >> 3, d8 = (e & 7) * 8;
        const uint4 v = *(const uint4*)(proj + (size_t)(b * 4096 + t0 + t) * NPROJ + 2048 + h * 64 + d8);
        bfu* tp = tile + d8 * 266 + t;
        tp[0] = (bfu)(v.x & 0xffff); tp[266] = (bfu)(v.x >> 16); tp[2 * 266] = (bfu)(v.y & 0xffff); tp[3 * 266] = (bfu)(v.y >> 16);
        tp[4 * 266] = (bfu)(v.z & 0xffff); tp[5 * 266] = (bfu)(v.z >> 16); tp[6 * 266] = (bfu)(v.w & 0xffff); tp[7 * 266] = (bfu)(v.w >> 16);
    }
    __syncthreads();
#pragma unroll
    for (int br = 0; br < 3; ++br) {
        const int dsh = 2 * br, dil = 1 << dsh, nch = (256 >> dsh) >> 3;
#pragma unroll
        for (int i = 0; i < 4; ++i) {
            const int e = tid + 512 * i, d = e >> 5, rem = e & 31, ch = rem % nch, r = rem / nch;
            const bfu* tp = tile + d * 266 + r + ((ch * 8) << dsh);
            uint4 o;
            o.x = (unsigned)tp[0] | ((unsigned)tp[dil] << 16); o.y = (unsigned)tp[2 * dil] | ((unsigned)tp[3 * dil] << 16);
            o.z = (unsigned)tp[4 * dil] | ((unsigned)tp[5 * dil] << 16); o.w = (unsigned)tp[6 * dil] | ((unsigned)tp[7 * dil] << 16);
            *(uint4*)(vt + (size_t)br * VT_SZ + ((size_t)(bh * 64 + d)) * 4096 + r * (4096 >> dsh) + (t0 >> dsh) + ch * 8) = o;
        }
    }
    __syncthreads();
}

__device__ __forceinline__ void dt_task(const Params& p, int wt) {
    const int lane = threadIdx.x & 63, l15 = lane & 15, quad = lane >> 4, r0 = wt * 16;
    const bfu* xb = (const bfu*)(p.ws + WS_XB) + (size_t)(r0 + l15) * 1024 + quad * 8;
    const bfu* wd = (const bfu*)(p.ws + WS_WDT) + (size_t)l15 * 1024 + quad * 8;
    f32x4 acc = {0.f, 0.f, 0.f, 0.f};
#pragma unroll 8
    for (int ks = 0; ks < 32; ++ks) acc = MFMA16(ld8g(xb + ks * 32), ld8g(wd + ks * 32), acc);
    float* dt = (float*)(p.ws + WS_DT);
    const float bias = p.dt_bias[l15];
#pragma unroll
    for (int j = 0; j < 4; ++j) { const float v = acc[j] + bias; dt[(size_t)(r0 + quad * 4 + j) * 16 + l15] = (v > 20.f) ? v : log1pf(__expf(v)); }
}

__device__ __forceinline__ void phase2(const Params& p, unsigned char* lds, int bid, int G) {
    constexpr int U_CP = 0, U_CS = 32, U_VT = 1024, U_DT = 130, NU = U_CP + U_CS + U_VT + U_DT;
    const int tid = threadIdx.x;
    for (int u = bid; u < NU; u += G) {
        int j = u;
        if (j < U_VT) { vt_unit(p, j, (bfu*)lds); continue; }
        j -= U_VT;
        if (j < U_CP) { const int b = j >> 7, tt = j & 127; conv_run<false, 16>(p, b, b * 4096, tt * 32 + (tid >> 8) * 16, (tid & 255) * 8); continue; }
        j -= U_CP;
        if (j < U_CS) { conv_run<true, 4>(p, j, MP + j * 8, (tid >> 8) * 4, (tid & 255) * 8); continue; }
        j -= U_CS;
        { const int wt = j * 8 + (tid >> 6); if (wt < MT / 16) dt_task(p, wt); }
    }
}

struct AttnUnit { int bh, br, r, i_start; };
__device__ __forceinline__ AttnUnit attn_decode(int bh, int br, int sub) {
    AttnUnit u; u.bh = bh; u.br = br;
    u.r = (br == 0) ? 0 : (br == 1 ? (sub & 3) : sub);
    u.i_start = ((br == 0) ? sub : (br == 1 ? (sub >> 2) : 0)) * 256;
    return u;
}
__device__ __forceinline__ void attn_stage_load(const Params& p, const AttnUnit u, uint4 (&sk)[6], uint4 (&sv)[6]) {
    const int h = u.bh & 15, b = u.bh >> 4, tid = threadIdx.x;
    const int dsh = 2 * u.br, nsub = 4096 >> dsh, k_lo = u.i_start - 128;
    const bfu* vt = (const bfu*)(p.ws + WS_VT) + (size_t)u.br * VT_SZ + (size_t)u.bh * 64 * 4096 + u.r * nsub;
    const bfu* kbase = (const bfu*)(p.ws + WS_PROJ) + (size_t)(b * 4096 + u.r) * NPROJ + 1024 + h * 64;
#pragma unroll
    for (int i = 0; i < 6; ++i) {
        const int e = tid + 512 * i;
        { const int key = e >> 3, c = e & 7; int ik = k_lo + key; ik = ik < 0 ? 0 : ik; sk[i] = *(const uint4*)(kbase + ((size_t)ik << dsh) * NPROJ + c * 8); }
        { const int d = e / 48, c = e - d * 48; int ik = k_lo + c * 8; ik = ik < 0 ? 0 : ik; sv[i] = *(const uint4*)(vt + (size_t)d * 4096 + ik); }
    }
}
__device__ __forceinline__ void attn_stage_store(const uint4 (&sk)[6], const uint4 (&sv)[6], unsigned char* ldsb) {
    bfu* Kl = (bfu*)ldsb; bfu* Vl = Kl + 384 * 72; const int tid = threadIdx.x;
#pragma unroll
    for (int i = 0; i < 6; ++i) {
        const int e = tid + 512 * i;
        { const int key = e >> 3, c = e & 7; *(uint4*)(Kl + key * 72 + c * 8) = sk[i]; }
        { const int d = e / 48, c = e - d * 48; *(uint4*)(Vl + d * 392 + c * 8) = sv[i]; }
    }
}
__device__ __forceinline__ void attn_qload(const Params& p, const AttnUnit u, bf16x8 (&qf)[4]) {
    const int h = u.bh & 15, b = u.bh >> 4, lane = threadIdx.x & 63, wave = __builtin_amdgcn_readfirstlane(threadIdx.x >> 6), l15 = lane & 15, quad = lane >> 4, dsh = 2 * u.br;
#pragma unroll
    for (int tt = 0; tt < 2; ++tt) {
        const int tq = u.r + ((u.i_start + 16 * (wave * 2 + tt) + l15) << dsh);
        const bfu* qp = (const bfu*)(p.ws + WS_PROJ) + (size_t)(b * 4096 + tq) * NPROJ + h * 64 + quad * 8;
        qf[2 * tt] = ld8g(qp); qf[2 * tt + 1] = ld8g(qp + 32);
    }
}
__device__ __forceinline__ void attn_compute(const Params& p, const AttnUnit u, unsigned char* ldsb, const bf16x8 (&qf)[4]) {
    const int bh = u.bh, br = u.br, r = u.r, i_start = u.i_start;
    const int h = bh & 15, b = bh >> 4;
    const int tid = threadIdx.x, lane = tid & 63, wave = __builtin_amdgcn_readfirstlane(tid >> 6), l15 = lane & 15, quad = lane >> 4;
    const bfu* Kl = (const bfu*)ldsb;
    const bfu* Vl = Kl + 384 * 72;
    const bfu* proj = (const bfu*)(p.ws + WS_PROJ);
    const int dsh = 2 * br;
    const float slope = exp2f(-0.5f * (float)(h + 1));
    const float NINF = -__builtin_inff();
    bfu* attb = (bfu*)(p.ws + WS_ATTB) + (size_t)br * ((size_t)MP * 1024);
    float* lse = (float*)(p.ws + WS_LSE) + (size_t)br * (MP * 16);
#pragma unroll 1
    for (int tt = 0; tt < 2; ++tt) {
        const int kb = 16 * (wave * 2 + tt);
        const int i0 = i_start + kb;
        const int tq = r + ((i0 + l15) << dsh);
        const bf16x8 q0 = tt ? qf[2] : qf[0], q1 = tt ? qf[3] : qf[1];
        f32x4 s[9];
#pragma unroll
        for (int kt = 0; kt < 9; ++kt) {
            if (kt % 3 == 0) __builtin_amdgcn_sched_barrier(0);
            const bfu* kp = Kl + (kb + 16 * kt + l15) * 72 + quad * 8;
            f32x4 a = {0.f, 0.f, 0.f, 0.f};
            a = MFMA16(*(const bf16x8*)kp, q0, a); a = MFMA16(*(const bf16x8*)(kp + 32), q1, a);
            s[kt] = a;
        }
        const int dbase = 128 + l15 - quad * 4;
        const int dmax = (i0 + l15) < 128 ? (i0 + l15) : 128;
        const float sd = slope * (float)(1 << dsh) * 1.4426950408889634f, nb = -sd * (float)dbase;
        float mx = NINF;
#pragma unroll
        for (int kt = 0; kt < 9; ++kt)
#pragma unroll
            for (int j = 0; j < 4; ++j) {
                const int cst = 16 * kt + j;
                const float bias = __builtin_fmaf(sd, (float)cst, nb);
                float v = __builtin_fmaf(s[kt][j], 0.125f * 1.4426950408889634f, bias);
                if (kt == 0 || kt == 8 || i_start == 0) v = ((unsigned)(dbase - cst) <= (unsigned)dmax) ? v : NINF;
                s[kt][j] = v; mx = fmaxf(mx, v);
            }
        mx = fmaxf(mx, __shfl_xor(mx, 16)); mx = fmaxf(mx, __shfl_xor(mx, 32));
        float den = 0.f;
#pragma unroll
        for (int kt = 0; kt < 9; ++kt)
#pragma unroll
            for (int j = 0; j < 4; ++j) { const float e = __builtin_amdgcn_exp2f(s[kt][j] - mx); s[kt][j] = e; den += e; }
        den += __shfl_xor(den, 16); den += __shfl_xor(den, 32);
        f32x4 o[4];
#pragma unroll
        for (int dt = 0; dt < 4; ++dt) o[dt] = (f32x4){0.f, 0.f, 0.f, 0.f};
#pragma unroll
        for (int kk = 0; kk < 5; ++kk) {
            uint4 pu; pu.x = pk2(s[2 * kk][0], s[2 * kk][1]); pu.y = pk2(s[2 * kk][2], s[2 * kk][3]);
            if (kk < 4) { pu.z = pk2(s[kk < 4 ? 2 * kk + 1 : 8][0], s[kk < 4 ? 2 * kk + 1 : 8][1]); pu.w = pk2(s[kk < 4 ? 2 * kk + 1 : 8][2], s[kk < 4 ? 2 * kk + 1 : 8][3]); }
            else { pu.z = 0u; pu.w = 0u; }
            const bf16x8 pf = __builtin_bit_cast(bf16x8, pu);
#pragma unroll
            for (int dt = 0; dt < 4; ++dt) {
                const bfu* vp = Vl + (dt * 16 + l15) * 392 + kb + 32 * kk + quad * 4;
                const uint2 lo = *(const uint2*)vp;
                uint2 hi; if (kk < 4) hi = *(const uint2*)(vp + 16); else { hi.x = 0u; hi.y = 0u; }
                o[dt] = MFMA16(mk8(lo, hi), pf, o[dt]);
            }
        }
        const float inv = 1.f / den;
        const size_t row = (size_t)(b * 4096 + tq);
#pragma unroll
        for (int dt = 0; dt < 4; ++dt) {
            uint2 ov; ov.x = pk2(o[dt][0] * inv, o[dt][1] * inv); ov.y = pk2(o[dt][2] * inv, o[dt][3] * inv);
            *(uint2*)(attb + row * 1024 + h * 64 + dt * 16 + quad * 4) = ov;
        }
        if (quad == 0) lse[row * 16 + h] = (mx + __log2f(den)) * 0.6931471805599453f;
    }
}

__device__ __forceinline__ void attn_sample_unit(const Params& p, int unit, float* lds) {
    const int h = unit & 15, b = unit >> 4;
    const int tid = threadIdx.x, lane = tid & 63, wave = tid >> 6, ks = lane >> 4, d4 = lane & 15;
    float* sbuf = lds + wave * 136;
    const int row = MP + b * 8 + wave;
    const bfu* proj = (const bfu*)(p.ws + WS_PROJ);
    const uint2 qu = *(const uint2*)(proj + (size_t)row * NPROJ + h * 64 + d4 * 4);
    const float q0 = bflo(qu.x) * 0.125f, q1 = bfhi(qu.x) * 0.125f, q2 = bflo(qu.y) * 0.125f, q3 = bfhi(qu.y) * 0.125f;
    const float slope = exp2f(-0.5f * (float)(h + 1));
    const float* kc = p.cache_k + ((size_t)b * 2048 * 16 + h) * 64 + d4 * 4;
    const float* vc = p.cache_v + ((size_t)b * 2048 * 16 + h) * 64 + d4 * 4;
    const float* kn = p.out + O_KS + ((size_t)b * 8 * 16 + h) * 64 + d4 * 4;
    const float* vn = p.out + O_VS + ((size_t)b * 8 * 16 + h) * 64 + d4 * 4;
    const float NINF = -__builtin_inff();
    float mr = NINF, lr = 0.f; float4 orun = make_float4(0.f, 0.f, 0.f, 0.f);
    for (int br = 0; br < 3; ++br) {
        const int dsh = 2 * br;
#pragma unroll 1
        for (int ob = 0; ob < 2; ++ob) {
            float4 kv[17];
#pragma unroll
            for (int i = 0; i < 17; ++i) {
                const int j = (ob * 17 + i) * 4 + ks, jc = j > 128 ? 128 : j;
                const int pos = 2048 + wave - (jc << dsh);
                const float* kp = (pos < 2048) ? kc + (size_t)pos * 1024 : kn + (size_t)(pos - 2048) * 1024;
                kv[i] = *(const float4*)kp;
            }
            float pr[17];
#pragma unroll
            for (int i = 0; i < 17; ++i) pr[i] = rowsum16(q0 * kv[i].x + q1 * kv[i].y + q2 * kv[i].z + q3 * kv[i].w);
#pragma unroll
            for (int i = 0; i < 17; ++i) {
                const int j = (ob * 17 + i) * 4 + ks;
                if (d4 == 0 && j <= 128) sbuf[j] = pr[i] - slope * (float)(j << dsh);
            }
        }
        __builtin_amdgcn_wave_barrier();
        const float v0 = sbuf[lane], v1 = sbuf[lane + 64], v2 = (lane == 0) ? sbuf[128] : NINF;
        const float m = wmax(fmaxf(fmaxf(v0, v1), v2));
        const float e0 = __expf(v0 - m), e1 = __expf(v1 - m), e2 = (lane == 0) ? __expf(v2 - m) : 0.f;
        const float den = wsum(e0 + e1 + e2);
        __builtin_amdgcn_wave_barrier();
        sbuf[lane] = e0; sbuf[lane + 64] = e1; if (lane == 0) sbuf[128] = e2;
        __builtin_amdgcn_wave_barrier();
        float4 acc = make_float4(0.f, 0.f, 0.f, 0.f);
#pragma unroll 1
        for (int ob = 0; ob < 2; ++ob) {
            float4 vv[17];
#pragma unroll
            for (int i = 0; i < 17; ++i) {
                const int j = (ob * 17 + i) * 4 + ks, jc = j > 128 ? 128 : j;
                const int pos = 2048 + wave - (jc << dsh);
                const float* vp = (pos < 2048) ? vc + (size_t)pos * 1024 : vn + (size_t)(pos - 2048) * 1024;
                vv[i] = *(const float4*)vp;
            }
#pragma unroll
            for (int i = 0; i < 17; ++i) {
                const int j = (ob * 17 + i) * 4 + ks, jc = j > 128 ? 128 : j;
                const float pj = (j <= 128) ? sbuf[jc] : 0.f;
                acc.x += pj * vv[i].x; acc.y += pj * vv[i].y; acc.z += pj * vv[i].z; acc.w += pj * vv[i].w;
            }
        }
        acc.x += __shfl_xor(acc.x, 16); acc.y += __shfl_xor(acc.y, 16); acc.z += __shfl_xor(acc.z, 16); acc.w += __shfl_xor(acc.w, 16);
        acc.x += __shfl_xor(acc.x, 32); acc.y += __shfl_xor(acc.y, 32); acc.z += __shfl_xor(acc.z, 32); acc.w += __shfl_xor(acc.w, 32);
        const float mn = fmaxf(mr, m), a = __expf(mr - mn), bb = __expf(m - mn);
        orun.x = orun.x * a + acc.x * bb; orun.y = orun.y * a + acc.y * bb; orun.z = orun.z * a + acc.z * bb; orun.w = orun.w * a + acc.w * bb;
        lr = lr * a + den * bb; mr = mn;
        __builtin_amdgcn_wave_barrier();
    }
    if (ks == 0) {
        const float inv = 1.f / lr;
        uint2 o; o.x = pk2(orun.x * inv, orun.y * inv); o.y = pk2(orun.z * inv, orun.w * inv);
        *(uint2*)((bfu*)(p.ws + WS_ATT) + (size_t)row * 1024 + h * 64 + d4 * 4) = o;
    }
}

__device__ __forceinline__ void ssd_cumsum(const Params& p, int row0, int g, float* csb, float* dtb) {
    const int tid = threadIdx.x, hh = tid >> 7, l = tid & 127, h = g * 4 + hh, lane = tid & 63;
    const float dt = ((const float*)(p.ws + WS_DT))[(size_t)(row0 + l) * 16 + h];
    const float a = -__expf(p.a_log[h]);
    float v = dt * a;
#pragma unroll
    for (int off = 1; off < 64; off <<= 1) { const float t = __shfl_up(v, off); if (lane >= off) v += t; }
    dtb[tid] = dt; csb[tid] = v;
    __syncthreads();
    if (l >= 64) { v += csb[hh * 128 + 63]; }
    __syncthreads();
    csb[tid] = v;
    __syncthreads();
}

__device__ __forceinline__ void conv4x8(const Params& p, int b, int c, int l0, int ch, float (&o)[4][8]) {
    const bfu* proj = (const bfu*)(p.ws + WS_PROJ);
    bfu* xbc = (bfu*)(p.ws + WS_XBC);
    float w0[8], w1[8], w2[8], w3[8], cb[8];
    ld8f32(p.conv_w + ch, w0); ld8f32(p.conv_w + 2048 + ch, w1); ld8f32(p.conv_w + 4096 + ch, w2); ld8f32(p.conv_w + 6144 + ch, w3); ld8f32(p.conv_b + ch, cb);
    const int t0 = c * 128 + l0;
    const size_t rowb = (size_t)b * 4096;
    float r[7][8];
#pragma unroll
    for (int k = 0; k < 7; ++k) {
        const int t = t0 - 3 + k;
        ld8f(proj + (rowb + (t < 0 ? 0 : t)) * NPROJ + 4096 + ch, r[k]);
        if (k < 3) {
#pragma unroll
            for (int j = 0; j < 8; ++j) r[k][j] = (t >= 0) ? r[k][j] : 0.f;
        }
    }
#pragma unroll
    for (int k = 0; k < 4; ++k) {
#pragma unroll
        for (int j = 0; j < 8; ++j) o[k][j] = silu_f(cb[j] + w0[j] * r[k][j] + w1[j] * r[k + 1][j] + w2[j] * r[k + 2][j] + w3[j] * r[k + 3][j]);
        uint4 ov; ov.x = pk2(o[k][0], o[k][1]); ov.y = pk2(o[k][2], o[k][3]); ov.z = pk2(o[k][4], o[k][5]); ov.w = pk2(o[k][6], o[k][7]);
        *(uint4*)(xbc + (rowb + t0 + k) * 2048 + ch) = ov;
        if (t0 + k >= 4093) {
            float* dst = p.out + O_CP + ((size_t)b * 3 + (t0 + k - 4093)) * 2048 + ch;
            *(float4*)dst = make_float4(r[k + 3][0], r[k + 3][1], r[k + 3][2], r[k + 3][3]); *(float4*)(dst + 4) = make_float4(r[k + 3][4], r[k + 3][5], r[k + 3][6], r[k + 3][7]);
        }
    }
}

__device__ __forceinline__ void ssd_s1_unit(const Params& p, int unit, unsigned char* ldsb) {
    const int g = unit & 3, c = (unit >> 2) & 31, b = unit >> 7;
    const int tid = threadIdx.x, lane = tid & 63, wave = __builtin_amdgcn_readfirstlane(tid >> 6), l15 = lane & 15, quad = lane >> 4;
    bfu* BT = (bfu*)ldsb;
    bfu* XT = BT + 128 * 136;
    float* csb = (float*)(XT + 256 * 136);
    float* dtb = csb + 512;
    const int row0 = b * 4096 + c * 128;
    ssd_cumsum(p, row0, g, csb, dtb);
    {
        const int hh = tid >> 7, l = tid & 127;
        const float end = csb[hh * 128 + 127], v = csb[tid], dt = dtb[tid];
        __syncthreads();
        dtb[tid] = dt * __expf(end - v);
        if (l == 127) ((float*)(p.ws + WS_DECAY))[(b * 32 + c) * 16 + g * 4 + hh] = __expf(v);
    }
    __syncthreads();
    {
        const int cgrp = tid & 15, l0 = (tid >> 4) * 4;
        float o[4][8];
        conv4x8(p, b, c, l0, 1024 + g * 128 + cgrp * 8, o);
#pragma unroll
        for (int j = 0; j < 8; ++j) { uint2 w; w.x = pk2(o[0][j], o[1][j]); w.y = pk2(o[2][j], o[3][j]); *(uint2*)(BT + (cgrp * 8 + j) * 136 + l0) = w; }
        conv4x8(p, b, c, l0, 1536 + g * 128 + cgrp * 8, o);
    }
#pragma unroll 1
    for (int i = 0; i < 2; ++i) {
        const int e = tid + 512 * i, cg32 = e & 31, l0 = (e >> 5) * 4;
        float o[4][8];
        conv4x8(p, b, c, l0, g * 256 + cg32 * 8, o);
        const float* wl = dtb + (cg32 >> 3) * 128 + l0;
        const float wa = wl[0], wb = wl[1], wc_ = wl[2], wd = wl[3];
#pragma unroll
        for (int j = 0; j < 8; ++j) { uint2 w; w.x = pk2(o[0][j] * wa, o[1][j] * wb); w.y = pk2(o[2][j] * wc_, o[3][j] * wd); *(uint2*)(XT + (cg32 * 8 + j) * 136 + l0) = w; }
    }
    __syncthreads();
    for (int hh = 0; hh < 4; ++hh) {
        const int h = g * 4 + hh;
        const bfu* XTh = XT + hh * 64 * 136;
        f32x4 acc[4];
#pragma unroll
        for (int mt = 0; mt < 4; ++mt) acc[mt] = (f32x4){0.f, 0.f, 0.f, 0.f};
#pragma unroll
        for (int ks = 0; ks < 4; ++ks) {
            const bf16x8 bfr = *(const bf16x8*)(BT + (wave * 16 + l15) * 136 + ks * 32 + quad * 8);
#pragma unroll
            for (int mt = 0; mt < 4; ++mt) { const bf16x8 afr = *(const bf16x8*)(XTh + (mt * 16 + l15) * 136 + ks * 32 + quad * 8); acc[mt] = MFMA16(bfr, afr, acc[mt]); }
        }
        bfu* st = (bfu*)(p.ws + WS_STATES) + ((size_t)((b * 32 + c) * 16 + h) * 64) * 128;
#pragma unroll
        for (int mt = 0; mt < 4; ++mt) { uint2 o; o.x = pk2(acc[mt][0], acc[mt][1]); o.y = pk2(acc[mt][2], acc[mt][3]); *(uint2*)(st + (mt * 16 + l15) * 128 + wave * 16 + quad * 4) = o; }
    }
    __syncthreads();
}

__device__ __forceinline__ void ssd_s3_unit(const Params& p, int unit, unsigned char* ldsb) {
    const int g = unit & 3, c = (unit >> 2) & 31, b = unit >> 7;
    const int tid = threadIdx.x, lane = tid & 63, wave = __builtin_amdgcn_readfirstlane(tid >> 6), l15 = lane & 15, quad = lane >> 4;
    bfu* Cs = (bfu*)ldsb;
    bfu* Bs = Cs + 128 * 136;
    bfu* XT4 = Bs + 128 * 136;
    float* csb = (float*)(XT4 + 256 * 136);
    float* dtb = csb + 512;
    const int row0 = b * 4096 + c * 128;
    const bfu* xbc = (const bfu*)(p.ws + WS_XBC);
    const bfu* proj = (const bfu*)(p.ws + WS_PROJ);
    ssd_cumsum(p, row0, g, csb, dtb);
#pragma unroll
    for (int i = 0; i < 4; ++i) {
        const int e = tid + 512 * i, l = e >> 4, n8 = (e & 15) * 8;
        *(uint4*)(Bs + l * 136 + n8) = *(const uint4*)(xbc + (size_t)(row0 + l) * 2048 + 1024 + g * 128 + n8);
        *(uint4*)(Cs + l * 136 + n8) = *(const uint4*)(xbc + (size_t)(row0 + l) * 2048 + 1536 + g * 128 + n8);
    }
#pragma unroll
    for (int i = 0; i < 8; ++i) {
        const int e = tid + 512 * i, l = e & 127, p8 = (e >> 7) * 8;
        const uint4 v = *(const uint4*)(xbc + (size_t)(row0 + l) * 2048 + g * 256 + p8);
        bfu* tp = XT4 + p8 * 136 + l;
        tp[0] = (bfu)(v.x & 0xffff); tp[136] = (bfu)(v.x >> 16); tp[2 * 136] = (bfu)(v.y & 0xffff); tp[3 * 136] = (bfu)(v.y >> 16);
        tp[4 * 136] = (bfu)(v.z & 0xffff); tp[5 * 136] = (bfu)(v.z >> 16); tp[6 * 136] = (bfu)(v.w & 0xffff); tp[7 * 136] = (bfu)(v.w >> 16);
    }
    __syncthreads();
    f32x4 cbt[8];
#pragma unroll
    for (int st = 0; st < 8; ++st) {
        f32x4 a = {0.f, 0.f, 0.f, 0.f};
        if (st <= wave) {
#pragma unroll
            for (int ks = 0; ks < 4; ++ks)
                a = MFMA16(*(const bf16x8*)(Bs + (st * 16 + l15) * 136 + ks * 32 + quad * 8), *(const bf16x8*)(Cs + (wave * 16 + l15) * 136 + ks * 32 + quad * 8), a);
        }
        cbt[st] = a;
    }
    const int lrow = wave * 16 + l15;
    for (int hh = 0; hh < 4; ++hh) {
        const int h = g * 4 + hh;
        const bfu* XT = XT4 + hh * 64 * 136;
        const float csl = csb[hh * 128 + lrow];
        f32x4 acc[4];
#pragma unroll
        for (int mt = 0; mt < 4; ++mt) acc[mt] = (f32x4){0.f, 0.f, 0.f, 0.f};
        const bfu* hp = (const bfu*)(p.ws + WS_HPREV) + ((size_t)((b * 32 + c) * 16 + h) * 64) * 128;
        bf16x8 hf[16];
#pragma unroll
        for (int i = 0; i < 16; ++i) hf[i] = ld8g(hp + (size_t)((i & 3) * 16 + l15) * 128 + (i >> 2) * 32 + quad * 8);
        __builtin_amdgcn_sched_barrier(0);
#pragma unroll
        for (int ks = 0; ks < 4; ++ks) {
            const bf16x8 bfr = *(const bf16x8*)(Cs + lrow * 136 + ks * 32 + quad * 8);
#pragma unroll
            for (int mt = 0; mt < 4; ++mt) acc[mt] = MFMA16(hf[ks * 4 + mt], bfr, acc[mt]);
        }
        const float el = __expf(csl);
#pragma unroll
        for (int mt = 0; mt < 4; ++mt) { acc[mt][0] *= el; acc[mt][1] *= el; acc[mt][2] *= el; acc[mt][3] *= el; }
#pragma unroll
        for (int kk = 0; kk < 4; ++kk) {
            if (2 * kk <= wave) {
                float mv[8];
#pragma unroll
                for (int j = 0; j < 8; ++j) {
                    const int tile = 2 * kk + (j >> 2), s = tile * 16 + quad * 4 + (j & 3);
                    const float cbv = cbt[tile][j & 3];
                    const float e = __expf(csl - csb[hh * 128 + s]) * dtb[hh * 128 + s];
                    mv[j] = (s <= lrow) ? cbv * e : 0.f;
                }
                uint4 pu; pu.x = pk2(mv[0], mv[1]); pu.y = pk2(mv[2], mv[3]); pu.z = pk2(mv[4], mv[5]); pu.w = pk2(mv[6], mv[7]);
                const bf16x8 pf = __builtin_bit_cast(bf16x8, pu);
#pragma unroll
                for (int mt = 0; mt < 4; ++mt) {
                    const bfu* xp = XT + (mt * 16 + l15) * 136 + 32 * kk + quad * 4;
                    acc[mt] = MFMA16(mk8(*(const uint2*)xp, *(const uint2*)(xp + 16)), pf, acc[mt]);
                }
            }
        }
        const float dsk = p.d_skip[h];
        const size_t row = (size_t)(row0 + lrow);
        bfu* yg = (bfu*)(p.ws + WS_YG);
#pragma unroll
        for (int mt = 0; mt < 4; ++mt) {
            const int pc = h * 64 + mt * 16 + quad * 4;
            const uint2 xu = *(const uint2*)(xbc + row * 2048 + pc);
            const uint2 zu = *(const uint2*)(proj + row * NPROJ + 3072 + pc);
            const float y0 = (acc[mt][0] + dsk * bflo(xu.x)) * silu_f(bflo(zu.x)), y1 = (acc[mt][1] + dsk * bfhi(xu.x)) * silu_f(bfhi(zu.x));
            const float y2 = (acc[mt][2] + dsk * bflo(xu.y)) * silu_f(bflo(zu.y)), y3 = (acc[mt][3] + dsk * bfhi(xu.y)) * silu_f(bfhi(zu.y));
            uint2 o; o.x = pk2(y0, y1); o.y = pk2(y2, y3);
            *(uint2*)(yg + row * 1024 + pc) = o;
        }
    }
    __syncthreads();
}

__device__ __forceinline__ void ssd_sample_unit(const Params& p, int unit, float* lds) {
    const int h = unit & 15, b = unit >> 4, g = h >> 2, tid = threadIdx.x;
    float* Bf = lds; float* Cf = Bf + 1024; float* xsf = Cf + 1024; float* cbm = xsf + 512; float* csb = cbm + 64; float* dtb = csb + 8;
    const int row0 = MP + b * 8;
    const bfu* xbc = (const bfu*)(p.ws + WS_XBC);
    const bfu* proj = (const bfu*)(p.ws + WS_PROJ);
    {
        const int l = tid >> 6, n2 = (tid & 63) * 2;
        const unsigned ub = *(const unsigned*)(xbc + (size_t)(row0 + l) * 2048 + 1024 + g * 128 + n2);
        const unsigned uc = *(const unsigned*)(xbc + (size_t)(row0 + l) * 2048 + 1536 + g * 128 + n2);
        Bf[l * 128 + n2] = bflo(ub); Bf[l * 128 + n2 + 1] = bfhi(ub); Cf[l * 128 + n2] = bflo(uc); Cf[l * 128 + n2 + 1] = bfhi(uc);
        xsf[tid] = bf2f(xbc[(size_t)(row0 + l) * 2048 + h * 64 + (tid & 63)]);
        if (tid < 8) dtb[tid] = ((const float*)(p.ws + WS_DT))[(size_t)(row0 + tid) * 16 + h];
    }
    __syncthreads();
    if (tid == 0) { const float a = -__expf(p.a_log[h]); float run = 0.f; for (int l = 0; l < 8; ++l) { run += dtb[l] * a; csb[l] = run; } }
    __syncthreads();
    if (tid < 64) {
        const int l = tid >> 3, s = tid & 7;
        float d = 0.f;
        if (s <= l) { for (int n = 0; n < 128; ++n) d += Cf[l * 128 + n] * Bf[s * 128 + n]; d *= __expf(csb[l] - csb[s]) * dtb[s]; }
        cbm[tid] = d;
    }
    __syncthreads();
    const int pp = tid >> 3, nn = tid & 7;
    const size_t soff = ((size_t)(b * 16 + h) * 64 + pp) * 128 + nn * 16;
    const float* hp = p.state_ssm + soff;
    float4 h0 = *(const float4*)hp, h1 = *(const float4*)(hp + 4), h2 = *(const float4*)(hp + 8), h3 = *(const float4*)(hp + 12);
    float myoff = 0.f;
#pragma unroll
    for (int l = 0; l < 8; ++l) {
        const float* cp = Cf + l * 128 + nn * 16;
        float part = cp[0] * h0.x + cp[1] * h0.y + cp[2] * h0.z + cp[3] * h0.w + cp[4] * h1.x + cp[5] * h1.y + cp[6] * h1.z + cp[7] * h1.w
                   + cp[8] * h2.x + cp[9] * h2.y + cp[10] * h2.z + cp[11] * h2.w + cp[12] * h3.x + cp[13] * h3.y + cp[14] * h3.z + cp[15] * h3.w;
        part += __shfl_xor(part, 1); part += __shfl_xor(part, 2); part += __shfl_xor(part, 4);
        if (nn == l) myoff = part;
    }
    const float cs7 = csb[7], e7 = __expf(cs7);
    h0.x *= e7; h0.y *= e7; h0.z *= e7; h0.w *= e7; h1.x *= e7; h1.y *= e7; h1.z *= e7; h1.w *= e7;
    h2.x *= e7; h2.y *= e7; h2.z *= e7; h2.w *= e7; h3.x *= e7; h3.y *= e7; h3.z *= e7; h3.w *= e7;
#pragma unroll
    for (int l = 0; l < 8; ++l) {
        const float w = __expf(cs7 - csb[l]) * dtb[l] * xsf[l * 64 + pp];
        const float* bp = Bf + l * 128 + nn * 16;
        h0.x += bp[0] * w; h0.y += bp[1] * w; h0.z += bp[2] * w; h0.w += bp[3] * w; h1.x += bp[4] * w; h1.y += bp[5] * w; h1.z += bp[6] * w; h1.w += bp[7] * w;
        h2.x += bp[8] * w; h2.y += bp[9] * w; h2.z += bp[10] * w; h2.w += bp[11] * w; h3.x += bp[12] * w; h3.y += bp[13] * w; h3.z += bp[14] * w; h3.w += bp[15] * w;
    }
    float* so = p.out + O_SS + soff;
    *(float4*)so = h0; *(float4*)(so + 4) = h1; *(float4*)(so + 8) = h2; *(float4*)(so + 12) = h3;
    {
        const int l = nn;
        float y = myoff * __expf(csb[l]);
#pragma unroll
        for (int s = 0; s < 8; ++s) y += cbm[l * 8 + s] * xsf[s * 64 + pp];
        y += p.d_skip[h] * xsf[l * 64 + pp];
        const float z = bf2f(proj[(size_t)(row0 + l) * NPROJ + 3072 + h * 64 + pp]);
        ((bfu*)(p.ws + WS_YG))[(size_t)(row0 + l) * 1024 + h * 64 + pp] = (bfu)f2bf(y * silu_f(z));
    }
    __syncthreads();
}

__device__ __forceinline__ void phase3(const Params& p, unsigned char* lds, int bid, int G) {
    {
        const bool xa = (G == 256);
        const int x = bid & 7, sl = bid >> 3;
        const int nun = xa ? 12 : (3072 - bid + G - 1) / G;
#define ATTN_UNIT_OF(i, U) { const int v_ = xa ? sl + 32 * (i) : bid + G * (i), rest_ = v_ % 48; U = attn_decode(xa ? x + 8 * (v_ / 48) : v_ / 48, rest_ >> 4, rest_ & 15); }
        for (int i = 0; i < nun; ++i) {
            AttnUnit uc; ATTN_UNIT_OF(i, uc);
            bf16x8 qf[4]; attn_qload(p, uc, qf);
            { uint4 sk_[6], sv_[6]; attn_stage_load(p, uc, sk_, sv_); attn_stage_store(sk_, sv_, lds); }
            __syncthreads();
            attn_compute(p, uc, lds, qf);
            __syncthreads();
        }
#undef ATTN_UNIT_OF
    }
    for (int u = bid; u < 512; u += G) attn_sample_unit(p, u, (float*)lds);
    __syncthreads();
    for (int u = bid; u < 512; u += G) ssd_s1_unit(p, u, lds);
    for (int u = bid; u < 512; u += G) ssd_sample_unit(p, u, (float*)lds);
}

__device__ __forceinline__ void phase4_scan(const Params& p, int bid, int G) {
    const bfu* states = (const bfu*)(p.ws + WS_STATES);
    const float* decay = (const float*)(p.ws + WS_DECAY);
    bfu* hprev = (bfu*)(p.ws + WS_HPREV);
    for (int i = bid * 512 + threadIdx.x; i < 131072; i += G * 512) {
        const int e = i * 4, n = e & 127, pp = (e >> 7) & 63, h = (e >> 13) & 15, b = e >> 17;
        float4 hc = make_float4(0.f, 0.f, 0.f, 0.f);
#pragma unroll 16
        for (int c = 0; c < 32; ++c) {
            const float dec = decay[(b * 32 + c) * 16 + h];
            const size_t off = ((size_t)((b * 32 + c) * 16 + h) * 64 + pp) * 128 + n;
            const uint2 su = *(const uint2*)(states + off);
            const float4 st = make_float4(bflo(su.x), bfhi(su.x), bflo(su.y), bfhi(su.y));
            uint2 o; o.x = pk2(hc.x, hc.y); o.y = pk2(hc.z, hc.w);
            *(uint2*)(hprev + off) = o;
            hc.x = hc.x * dec + st.x; hc.y = hc.y * dec + st.y; hc.z = hc.z * dec + st.z; hc.w = hc.w * dec + st.w;
        }
        *(float4*)(p.out + O_SP + ((size_t)(b * 16 + h) * 64 + pp) * 128 + n) = hc;
    }
}

__device__ __forceinline__ void rms_half(const bfu* src, const float* gam, bfu* dst, int lane) {
    float a[8], c[8];
    ld8f(src + lane * 8, a); ld8f(src + 512 + lane * 8, c);
    float ss = 0.f;
#pragma unroll
    for (int j = 0; j < 8; ++j) ss += a[j] * a[j] + c[j] * c[j];
    ss = wsum(ss);
    const float rs = rsqrtf(ss * (1.f / 1024.f) + EPS);
    float g0[8], g1[8]; ld8f32(gam + lane * 8, g0); ld8f32(gam + 512 + lane * 8, g1);
    uint4 o0, o1;
    o0.x = pk2(a[0] * rs * g0[0], a[1] * rs * g0[1]); o0.y = pk2(a[2] * rs * g0[2], a[3] * rs * g0[3]); o0.z = pk2(a[4] * rs * g0[4], a[5] * rs * g0[5]); o0.w = pk2(a[6] * rs * g0[6], a[7] * rs * g0[7]);
    o1.x = pk2(c[0] * rs * g1[0], c[1] * rs * g1[1]); o1.y = pk2(c[2] * rs * g1[2], c[3] * rs * g1[3]); o1.z = pk2(c[4] * rs * g1[4], c[5] * rs * g1[5]); o1.w = pk2(c[6] * rs * g1[6], c[7] * rs * g1[7]);
    *(uint4*)(dst + lane * 8) = o0; *(uint4*)(dst + 512 + lane * 8) = o1;
}
__device__ __forceinline__ void attn_merge_rms(const Params& p, int row, bfu* dst, int lane) {
    const bfu* attb = (const bfu*)(p.ws + WS_ATTB); const float* lse = (const float*)(p.ws + WS_LSE);
    float a[8], c[8];
#pragma unroll
    for (int j = 0; j < 8; ++j) { a[j] = 0.f; c[j] = 0.f; }
    const int h0 = lane >> 3, h1 = 8 + (lane >> 3);
    float l0[3], l1[3];
#pragma unroll
    for (int br = 0; br < 3; ++br) { l0[br] = lse[(size_t)br * (MP * 16) + (size_t)row * 16 + h0]; l1[br] = lse[(size_t)br * (MP * 16) + (size_t)row * 16 + h1]; }
    const float m0 = fmaxf(fmaxf(l0[0], l0[1]), l0[2]), m1 = fmaxf(fmaxf(l1[0], l1[1]), l1[2]);
    float w0[3], w1[3];
#pragma unroll
    for (int br = 0; br < 3; ++br) { w0[br] = __expf(l0[br] - m0); w1[br] = __expf(l1[br] - m1); }
    const float i0 = 1.f / (w0[0] + w0[1] + w0[2]), i1 = 1.f / (w1[0] + w1[1] + w1[2]);
#pragma unroll
    for (int br = 0; br < 3; ++br) {
        float x[8], y[8];
        const bfu* src = attb + (size_t)br * ((size_t)MP * 1024) + (size_t)row * 1024;
        ld8f(src + lane * 8, x); ld8f(src + 512 + lane * 8, y);
        const float f0 = w0[br] * i0, f1 = w1[br] * i1;
#pragma unroll
        for (int j = 0; j < 8; ++j) { a[j] += f0 * x[j]; c[j] += f1 * y[j]; }
    }
    float ss = 0.f;
#pragma unroll
    for (int j = 0; j < 8; ++j) ss += a[j] * a[j] + c[j] * c[j];
    ss = wsum(ss);
    const float rs = rsqrtf(ss * (1.f / 1024.f) + EPS);
    const float* gam = p.attn_g;
    float g0[8], g1[8]; ld8f32(gam + lane * 8, g0); ld8f32(gam + 512 + lane * 8, g1);
    uint4 o0, o1;
    o0.x = pk2(a[0] * rs * g0[0], a[1] * rs * g0[1]); o0.y = pk2(a[2] * rs * g0[2], a[3] * rs * g0[3]); o0.z = pk2(a[4] * rs * g0[4], a[5] * rs * g0[5]); o0.w = pk2(a[6] * rs * g0[6], a[7] * rs * g0[7]);
    o1.x = pk2(c[0] * rs * g1[0], c[1] * rs * g1[1]); o1.y = pk2(c[2] * rs * g1[2], c[3] * rs * g1[3]); o1.z = pk2(c[4] * rs * g1[4], c[5] * rs * g1[5]); o1.w = pk2(c[6] * rs * g1[6], c[7] * rs * g1[7]);
    *(uint4*)(dst + lane * 8) = o0; *(uint4*)(dst + 512 + lane * 8) = o1;
}
__device__ __forceinline__ void phase6(const Params& p, int bid, int G) {
    const int lane = threadIdx.x & 63, wave = threadIdx.x >> 6;
    const bfu* att = (const bfu*)(p.ws + WS_ATT); const bfu* yg = (const bfu*)(p.ws + WS_YG); bfu* mix = (bfu*)(p.ws + WS_MIX);
    for (int row = bid * 8 + wave; row < MT; row += G * 8) {
        if (row < MP) attn_merge_rms(p, row, mix + (size_t)row * 2048, lane);
        else rms_half(att + (size_t)row * 1024, p.attn_g, mix + (size_t)row * 2048, lane);
        rms_half(yg + (size_t)row * 1024, p.ssm_g, mix + (size_t)row * 2048 + 1024, lane);
    }
}
__device__ __forceinline__ void ln_phase(const float* pre, const float* gam, const float* bet, float* of32, bfu* obf, int bid, int G) {
    const int lane = threadIdx.x & 63, wave = threadIdx.x >> 6;
    for (int row = bid * 8 + wave; row < MT; row += G * 8) {
        const float* pr = pre + (size_t)row * 1024;
        float4 v[4];
        float s = 0.f;
#pragma unroll
        for (int i = 0; i < 4; ++i) { v[i] = *(const float4*)(pr + i * 256 + lane * 4); s += v[i].x + v[i].y + v[i].z + v[i].w; }
        const float mu = wsum(s) * (1.f / 1024.f);
        float q = 0.f;
#pragma unroll
        for (int i = 0; i < 4; ++i) { v[i].x -= mu; v[i].y -= mu; v[i].z -= mu; v[i].w -= mu; q += v[i].x * v[i].x + v[i].y * v[i].y + v[i].z * v[i].z + v[i].w * v[i].w; }
        const float rs = rsqrtf(wsum(q) * (1.f / 1024.f) + EPS);
#pragma unroll
        for (int i = 0; i < 4; ++i) {
            const int c = i * 256 + lane * 4;
            const float4 gg = *(const float4*)(gam + c), bb = *(const float4*)(bet + c);
            const float4 y = make_float4(v[i].x * rs * gg.x + bb.x, v[i].y * rs * gg.y + bb.y, v[i].z * rs * gg.z + bb.z, v[i].w * rs * gg.w + bb.w);
            if (of32) *(float4*)(of32 + (size_t)row * 1024 + c) = y;
            if (obf) { uint2 o; o.x = pk2(y.x, y.y); o.y = pk2(y.z, y.w); *(uint2*)(obf + (size_t)row * 1024 + c) = o; }
        }
    }
}


template <int K>
__device__ __forceinline__ void skinny_sample_gemm(const bfu* __restrict__ A, const bfu* __restrict__ Bt, const float* __restrict__ res, float* __restrict__ pre, float* ldsf, int bid) {
    const int tid = threadIdx.x, lane = tid & 63, wave = __builtin_amdgcn_readfirstlane(tid >> 6), l15 = lane & 15, quad = lane >> 4;
    const int rg = bid >> 4, cg = bid & 15;
    constexpr int KW = K / 8, NS = KW / 32;
    const bfu* ap = A + (size_t)(MP + rg * 16 + l15) * K + wave * KW + quad * 8;
    const bfu* bp = Bt + (size_t)(cg * 64 + l15) * K + wave * KW + quad * 8;
    f32x4 acc[4];
#pragma unroll
    for (int nt = 0; nt < 4; ++nt) acc[nt] = (f32x4){0.f, 0.f, 0.f, 0.f};
#pragma unroll
    for (int ks = 0; ks < NS; ++ks) {
        const bf16x8 af = ld8g(ap + ks * 32);
#pragma unroll
        for (int nt = 0; nt < 4; ++nt) acc[nt] = MFMA16(af, ld8g(bp + (size_t)nt * 16 * K + ks * 32), acc[nt]);
    }
#pragma unroll
    for (int nt = 0; nt < 4; ++nt)
#pragma unroll
        for (int j = 0; j < 4; ++j) ldsf[wave * 1024 + (quad * 4 + j) * 64 + nt * 16 + l15] = acc[nt][j];
    __syncthreads();
#pragma unroll
    for (int i = 0; i < 2; ++i) {
        const int e = tid + 512 * i, r = e >> 6, c = e & 63;
        float v = 0.f;
#pragma unroll
        for (int w = 0; w < 8; ++w) v += ldsf[w * 1024 + e];
        const size_t row = (size_t)(rg * 16 + r);
        pre[(MP + row) * 1024 + cg * 64 + c] = v + ALPHA * res[row * 1024 + cg * 64 + c];
    }
    __syncthreads();
}

template <bool RES_BF16>
struct EpiLn {
    static constexpr bool PERM = true, AFTER_DRAIN = true;
    const void* res; const float* gam; const float* bet; float* of32; bfu* obf;
    unsigned long long* xch;
    unsigned* cnt;
    unsigned* bar;
    __device__ __forceinline__ void operator()(const f32x4 (&)[2][2][4][2], const Unit&, int, int, int, int) const {}
    __device__ __forceinline__ void fused(f32x4 (&acc)[2][2][4][2], const Unit& u, int wr, int wc, int fr, int fq, PG8_LAS unsigned char* lds, int wid, int lane) const {
        PG8_LAS float* P = (PG8_LAS float*)lds;
        PG8_LAS float* S = (PG8_LAS float*)(lds + 8192);
        const int tid = threadIdx.x;
#pragma unroll
        for (int ai = 0; ai < 2; ++ai)
#pragma unroll
            for (int m = 0; m < 4; ++m) {
                const int rl = ai * 128 + wr * 64 + m * 16 + fr;
                const size_t roff = (size_t)(u.pm * 256 + rl) * 1024 + u.pn * 256 + wc * 32 + fq * 8;
                float s1 = 0.f, s2 = 0.f;
#pragma unroll
                for (int bj = 0; bj < 2; ++bj) {
                    float x[8];
                    if (RES_BF16) ld8f((const bfu*)res + roff + bj * 128, x);
                    else ld8f32((const float*)res + roff + bj * 128, x);
#pragma unroll
                    for (int n = 0; n < 2; ++n) {
                        f32x4 v = acc[ai][bj][m][n];
                        v[0] += ALPHA * x[4 * n]; v[1] += ALPHA * x[4 * n + 1]; v[2] += ALPHA * x[4 * n + 2]; v[3] += ALPHA * x[4 * n + 3];
                        acc[ai][bj][m][n] = v;
                        s1 += (v[0] + v[1]) + (v[2] + v[3]); s2 += (v[0] * v[0] + v[1] * v[1]) + (v[2] * v[2] + v[3] * v[3]);
                    }
                }
                s1 += __shfl_xor(s1, 16); s1 += __shfl_xor(s1, 32); s2 += __shfl_xor(s2, 16); s2 += __shfl_xor(s2, 32);
                {
                    PG8_LAS float* pd = (fq == 0) ? P + (rl * 4 + wc) * 2 : (PG8_LAS float*)(lds + 12288) + tid * 2;
                    pd[0] = s1; pd[1] = s2;
                }
            }
        __syncthreads();
        if (tid < 256) {
            const float a = P[tid * 8] + P[tid * 8 + 2] + P[tid * 8 + 4] + P[tid * 8 + 6], b = P[tid * 8 + 1] + P[tid * 8 + 3] + P[tid * 8 + 5] + P[tid * 8 + 7];
            const unsigned long long pk = (unsigned long long)__float_as_uint(a) | ((unsigned long long)__float_as_uint(b) << 32);
            __hip_atomic_store(xch + ((size_t)(u.pm * 256 + tid) * 4 + u.pn), pk, __ATOMIC_RELAXED, __HIP_MEMORY_SCOPE_AGENT);
        }
        asm volatile("s_waitcnt vmcnt(0)" ::: "memory");
        __syncthreads();
        if (tid == 0) {
            __builtin_amdgcn_fence(__ATOMIC_RELEASE, "agent");
            asm volatile("s_waitcnt vmcnt(0)" ::: "memory");
            unsigned* c = cnt + u.pm * 64;
            xb_add(c, 1u);
            XB_SPIN(xb_ld(c) < 4u, bar);
            __builtin_amdgcn_fence(__ATOMIC_ACQUIRE, "agent");
            asm volatile("s_waitcnt vmcnt(0)" ::: "memory");
        }
        __syncthreads();
        if (tid < 256) {
            float a = 0.f, b = 0.f;
#pragma unroll
            for (int t = 0; t < 4; ++t) {
                const unsigned long long pk = __hip_atomic_load(xch + ((size_t)(u.pm * 256 + tid) * 4 + t), __ATOMIC_RELAXED, __HIP_MEMORY_SCOPE_AGENT);
                a += __uint_as_float((unsigned)pk); b += __uint_as_float((unsigned)(pk >> 32));
            }
            const float mu = a * (1.f / 1024.f), var = fmaxf(b * (1.f / 1024.f) - mu * mu, 0.f);
            S[tid * 2] = mu; S[tid * 2 + 1] = rsqrtf(var + EPS);
        }
        __syncthreads();
#pragma unroll
        for (int bj = 0; bj < 2; ++bj) {
            const int col = u.pn * 256 + bj * 128 + wc * 32 + fq * 8;
            float gg[8], bb[8]; ld8f32(gam + col, gg); ld8f32(bet + col, bb);
#pragma unroll
            for (int ai = 0; ai < 2; ++ai)
#pragma unroll
                for (int m = 0; m < 4; ++m) {
                    const int rl = ai * 128 + wr * 64 + m * 16 + fr;
                    const float mu = S[rl * 2], rs = S[rl * 2 + 1];
                    const f32x4 v0 = acc[ai][bj][m][0], v1 = acc[ai][bj][m][1];
                    float y[8];
#pragma unroll
                    for (int j = 0; j < 4; ++j) { y[j] = (v0[j] - mu) * rs * gg[j] + bb[j]; y[4 + j] = (v1[j] - mu) * rs * gg[4 + j] + bb[4 + j]; }
                    const size_t off = (size_t)(u.pm * 256 + rl) * 1024 + col;
                    if (of32) { *(float4*)(of32 + off) = make_float4(y[0], y[1], y[2], y[3]); *(float4*)(of32 + off + 4) = make_float4(y[4], y[5], y[6], y[7]); }
                    if (obf) { uint4 o; o.x = pk2(y[0], y[1]); o.y = pk2(y[2], y[3]); o.z = pk2(y[4], y[5]); o.w = pk2(y[6], y[7]); *(uint4*)(obf + off) = o; }
                }
        }
    }
};
__device__ __forceinline__ void sample_rows_publish(unsigned* cnt_s, int bid) {
    asm volatile("s_waitcnt vmcnt(0)" ::: "memory");
    __syncthreads();
    if (threadIdx.x == 0) { __builtin_amdgcn_fence(__ATOMIC_RELEASE, "agent"); asm volatile("s_waitcnt vmcnt(0)" ::: "memory"); xb_add(cnt_s + (bid >> 4) * 64, 1u); }
}
__device__ __forceinline__ void sample_rows_ln(unsigned* cnt_s, unsigned* bar, const float* pre, const float* gam, const float* bet, float* of32, bfu* obf, int bid) {
    if (bid >= 32) return;
    if (threadIdx.x == 0) {
        unsigned* c = cnt_s + (bid >> 1) * 64;
        XB_SPIN(xb_ld(c) < 16u, bar);
        __builtin_amdgcn_fence(__ATOMIC_ACQUIRE, "agent");
        asm volatile("s_waitcnt vmcnt(0)" ::: "memory");
    }
    __syncthreads();
    const int lane = threadIdx.x & 63, wave = threadIdx.x >> 6, row = MP + bid * 8 + wave;
    const float* pr = pre + (size_t)row * 1024;
    float4 v[4];
    float s = 0.f;
#pragma unroll
    for (int i = 0; i < 4; ++i) { v[i] = *(const float4*)(pr + i * 256 + lane * 4); s += v[i].x + v[i].y + v[i].z + v[i].w; }
    const float mu = wsum(s) * (1.f / 1024.f);
    float q = 0.f;
#pragma unroll
    for (int i = 0; i < 4; ++i) { v[i].x -= mu; v[i].y -= mu; v[i].z -= mu; v[i].w -= mu; q += v[i].x * v[i].x + v[i].y * v[i].y + v[i].z * v[i].z + v[i].w * v[i].w; }
    const float rs = rsqrtf(wsum(q) * (1.f / 1024.f) + EPS);
#pragma unroll
    for (int i = 0; i < 4; ++i) {
        const int c = i * 256 + lane * 4;
        const float4 gg = *(const float4*)(gam + c), bb = *(const float4*)(bet + c);
        const float4 y = make_float4(v[i].x * rs * gg.x + bb.x, v[i].y * rs * gg.y + bb.y, v[i].z * rs * gg.z + bb.z, v[i].w * rs * gg.w + bb.w);
        if (of32) *(float4*)(of32 + (size_t)row * 1024 + c) = y;
        if (obf) { uint2 o; o.x = pk2(y.x, y.y); o.y = pk2(y.z, y.w); *(uint2*)(obf + (size_t)row * 1024 + c) = o; }
    }
}

constexpr int LDS_BYTES = 147456;
__device__ __forceinline__ const Params& kparams() {
    unsigned long long k = (unsigned long long)__builtin_amdgcn_kernarg_segment_ptr();
    asm volatile("" : "+s"(k));
#if defined(__HIP_DEVICE_COMPILE__)
    return *(const Params*)(const __attribute__((address_space(4))) Params*)k;
#else
    return *(const Params*)k;
#endif
}
#define KP (kparams())
__global__ void __launch_bounds__(512) fwd_kernel(Params p_unused) {
    extern __shared__ __attribute__((aligned(16))) unsigned char smem[];
    cg::grid_group grid = cg::this_grid();
    const int G = gridDim.x, bid = blockIdx.x;
    unsigned char* ws = KP.ws;
    PG8_LAS unsigned char* lds3 = (PG8_LAS unsigned char*)smem;

    unsigned* barw = (unsigned*)(ws + WS_BAR);
    volatile LAS unsigned* xst = (volatile LAS unsigned*)(lds3 + (LDS_BYTES - 64));
    if (bid == 0) for (int i = threadIdx.x; i < CTL_WORDS; i += 512) barw[i] = 0u;
    if (threadIdx.x < 4) xst[threadIdx.x] = 0u;
    phase0(KP, (float*)smem, bid, G);
    grid.sync();
    const XcdBarrier xb = xcd_barrier_post(barw, xst);
    {
        pg8::Gemm g{(const pg8::bf16_t*)(ws + WS_XB), (const pg8::bf16_t*)(ws + WS_WIN), MT, NPROJ, 1024};
        pg8::StaticOrder S; S.init(MT, NPROJ, G, bid);
        EpiIn E{(bfu*)(ws + WS_PROJ), KP.out};
        pg8::gemm_phase<EpiIn, pg8::StaticOrder, true, true>(lds3, g, S, E);
        after_p1_filler(KP, (float*)smem, bid, G);
    }
    xcd_barrier(xb);
    phase2(KP, smem, bid, G);
    xcd_barrier(xb);
    phase3(KP, smem, bid, G);
    xcd_barrier(xb);
    phase4_scan(KP, bid, G);
    xcd_barrier(xb);
    for (int u = bid; u < 512; u += G) ssd_s3_unit(KP, u, smem);
    xcd_barrier(xb);
    phase6(KP, bid, G);
    xcd_barrier(xb);
    unsigned* cnt_panel = barw + 4096;
    unsigned* cnt_rows = barw + 4096 + 2 * 64 * 64;
    unsigned long long* xch = (unsigned long long*)(ws + WS_XCH);
    if (G == 256) {
        {
            skinny_sample_gemm<2048>((const bfu*)(ws + WS_MIX), (const bfu*)(ws + WS_WOUT), KP.x_sample, (float*)(ws + WS_PRE), (float*)smem, bid);
            sample_rows_publish(cnt_rows, bid);
            pg8::Gemm g{(const pg8::bf16_t*)(ws + WS_MIX), (const pg8::bf16_t*)(ws + WS_WOUT), MP, 1024, 2048};
            pg8::StaticOrder S; S.init(MP, 1024, G, bid);
            EpiLn<true> E{(const bfu*)(ws + WS_XB), KP.ln1_g, KP.ln1_b, nullptr, (bfu*)(ws + WS_HDNB), xch, cnt_panel, barw};
            pg8::gemm_phase<EpiLn<true>, pg8::StaticOrder, false, true>(lds3, g, S, E);
            sample_rows_ln(cnt_rows, barw, (const float*)(ws + WS_PRE), KP.ln1_g, KP.ln1_b, (float*)(ws + WS_HDN), (bfu*)(ws + WS_HDNB), bid);
        }
        xcd_barrier(xb);
        {
            pg8::Gemm g{(const pg8::bf16_t*)(ws + WS_HDNB), (const pg8::bf16_t*)(ws + WS_WGU), MT, 2 * DFF, 1024};
            pg8::StaticOrder S; S.init(MT, 2 * DFF, G, bid);
            EpiGU E{(bfu*)(ws + WS_ACT)};
            pg8::gemm_phase<EpiGU, pg8::StaticOrder, true, true>(lds3, g, S, E);
            after_p9_filler(KP, (float*)smem, bid, G);
        }
        xcd_barrier(xb);
        {
            skinny_sample_gemm<DFF>((const bfu*)(ws + WS_ACT), (const bfu*)(ws + WS_WDN), (const float*)(ws + WS_HDN) + (size_t)MP * 1024, (float*)(ws + WS_PRE), (float*)smem, bid);
            sample_rows_publish(cnt_rows + 16 * 64, bid);
            pg8::Gemm g{(const pg8::bf16_t*)(ws + WS_ACT), (const pg8::bf16_t*)(ws + WS_WDN), MP, 1024, DFF};
            pg8::StaticOrder S; S.init(MP, 1024, G, bid);
            EpiLn<true> E{(const bfu*)(ws + WS_HDNB), KP.ln2_g, KP.ln2_b, KP.out + O_YP, nullptr, xch + (size_t)64 * 256 * 4, cnt_panel + 64 * 64, barw};
            pg8::gemm_phase<EpiLn<true>, pg8::StaticOrder, false, true>(lds3, g, S, E);
            sample_rows_ln(cnt_rows + 16 * 64, barw, (const float*)(ws + WS_PRE), KP.ln2_g, KP.ln2_b, KP.out + O_YP, nullptr, bid);
        }
        return;
    }
    {
        pg8::Gemm g{(const pg8::bf16_t*)(ws + WS_MIX), (const pg8::bf16_t*)(ws + WS_WOUT), MT, 1024, 2048};
        pg8::StaticOrder S; S.init(MT, 1024, G, bid);
        EpiRes E{(float*)(ws + WS_PRE), KP.x_prompt, KP.x_sample};
        pg8::gemm_phase<EpiRes, pg8::StaticOrder, true, true>(lds3, g, S, E);
    }
    xcd_barrier(xb);
    ln_phase((const float*)(ws + WS_PRE), KP.ln1_g, KP.ln1_b, (float*)(ws + WS_HDN), (bfu*)(ws + WS_HDNB), bid, G);
    xcd_barrier(xb);
    {
        pg8::Gemm g{(const pg8::bf16_t*)(ws + WS_HDNB), (const pg8::bf16_t*)(ws + WS_WGU), MT, 2 * DFF, 1024};
        pg8::StaticOrder S; S.init(MT, 2 * DFF, G, bid);
        EpiGU E{(bfu*)(ws + WS_ACT)};
        pg8::gemm_phase<EpiGU, pg8::StaticOrder, true, true>(lds3, g, S, E);
    }
    xcd_barrier(xb);
    {
        pg8::Gemm g{(const pg8::bf16_t*)(ws + WS_ACT), (const pg8::bf16_t*)(ws + WS_WDN), MT, 1024, DFF};
        pg8::StaticOrder S; S.init(MT, 1024, G, bid);
        EpiRes E{(float*)(ws + WS_PRE), (const float*)(ws + WS_HDN), (const float*)(ws + WS_HDN) + (size_t)MP * 1024};
        pg8::gemm_phase<EpiRes, pg8::StaticOrder, true, true>(lds3, g, S, E);
    }
    xcd_barrier(xb);
    ln_phase((const float*)(ws + WS_PRE), KP.ln2_g, KP.ln2_b, KP.out + O_YP, nullptr, bid, G);
}

extern "C" void kernel_launch(void* const* d_in, const int* in_sizes, int n_in, void* d_out, int out_size, void* d_ws, size_t ws_size, hipStream_t stream) {
    (void)in_sizes; (void)n_in; (void)out_size;
    static int grid_blocks = 0;
    if (!grid_blocks) {
        hipFuncSetAttribute((const void*)fwd_kernel, hipFuncAttributeMaxDynamicSharedMemorySize, LDS_BYTES);
        int dev = 0, cus = 0, per_cu = 0;
        hipGetDevice(&dev);
        hipDeviceGetAttribute(&cus, hipDeviceAttributeMultiprocessorCount, dev);
        hipOccupancyMaxActiveBlocksPerMultiprocessor(&per_cu, fwd_kernel, 512, LDS_BYTES);
        if (per_cu > 1) per_cu = 1;
        grid_blocks = cus * per_cu;
        if (grid_blocks <= 0) { fprintf(stderr, "occupancy query returned 0\n"); grid_blocks = 0; return; }
    }
    if (ws_size < WS_END) { fprintf(stderr, "workspace too small: %zu\n", ws_size); return; }
    Params p{};
    const float** pp = (const float**)&p;
    for (int i = 0; i < 22; ++i) pp[i] = (const float*)d_in[i];
    p.out = (float*)d_out; p.ws = (unsigned char*)d_ws;
    void* args[] = {&p};
    hipError_t e = hipLaunchCooperativeKernel((void*)fwd_kernel, dim3(grid_blocks), dim3(512), args, LDS_BYTES, stream);
    if (e != hipSuccess) fprintf(stderr, "cooperative launch failed: %s (grid %d)\n", hipGetErrorString(e), grid_blocks);
}
```
